# Optimizing an MI355X kernel written in HIP

```python
import jax, jax.numpy as jnp
from jax import lax
import numpy as np

D_MODEL = 1024
BATCH = 32
SEQ = 2048
DEPTH = 1

HEAD_DIM = 64
ROPE_THETA = 10000.0
BAND_BLOCK = 128
A_Q_HEADS = 8
A_KV_HEADS = 2
A_REP = A_Q_HEADS // A_KV_HEADS
A_WINDOW = 128
B_Q_HEADS = 8
B_KV_HEADS = 2
B_REP = B_Q_HEADS // B_KV_HEADS
CMP_BLOCK = 32
CMP_STRIDE = 16
CMP_HIDDEN = 256
SLC_BLOCK = 64
SLC_TOP_N = 16
B_WINDOW = 512
FFN_HIDDEN = ((-(-8 * D_MODEL // 3) + 255) // 256) * 256
ALPHA = (2 * DEPTH) ** 0.25
BETA = (8 * DEPTH) ** -0.25
LN_EPS = 1e-5
NEG = -1e30
BIG = 1e9

A_Q = A_Q_HEADS * HEAD_DIM
A_KV = A_KV_HEADS * HEAD_DIM
B_Q = B_Q_HEADS * HEAD_DIM
B_KV = B_KV_HEADS * HEAD_DIM
N_NSA_GATES = 3 * B_Q_HEADS
SPLIT_SIZES = (A_Q, A_KV, A_KV, B_Q, B_KV, B_KV, B_KV, B_KV, B_KV, B_KV, N_NSA_GATES, 2 * D_MODEL)
D_IN = A_Q + 2 * A_KV + B_Q + 6 * B_KV + N_NSA_GATES + 2 * D_MODEL

kernel_name = "hybrid_swa_sink_nsa_gated_deepnorm"


def layer_norm(x, g, b):
    xf = x.astype(jnp.float32)
    mu = jnp.mean(xf, axis=-1, keepdims=True)
    var = jnp.mean(jnp.square(xf - mu), axis=-1, keepdims=True)
    y = (xf - mu) * lax.rsqrt(var + LN_EPS)
    return (y * g + b).astype(x.dtype)


def rope(x, pos):
    half = x.shape[-1] // 2
    inv = ROPE_THETA ** (-jnp.arange(half, dtype=jnp.float32) / half)
    ang = pos.astype(jnp.float32)[:, None] * inv[None, :]
    cos, sin = jnp.cos(ang), jnp.sin(ang)
    xf = x.astype(jnp.float32)
    x1, x2 = xf[..., :half], xf[..., half:]
    return jnp.concatenate([x1 * cos - x2 * sin, x2 * cos + x1 * sin], axis=-1).astype(x.dtype)


def heads_q(t, n_kv, rep):
    b, s, _ = t.shape
    return t.reshape(b, s, n_kv, rep, HEAD_DIM).transpose(0, 2, 3, 1, 4)


def heads_kv(t, n_kv):
    b, s, _ = t.shape
    return t.reshape(b, s, n_kv, HEAD_DIM).transpose(0, 2, 1, 3)


def merge_heads(o):
    b, g, r, s, d = o.shape
    return o.transpose(0, 3, 1, 2, 4).reshape(b, s, g * r * d)


def banded_attention(q, k, v, window, sinks):
    b, g, r, s, d = q.shape
    nq = s // BAND_BLOCK
    nb = window // BAND_BLOCK
    pad = ((0, 0), (0, 0), (window, 0), (0, 0))
    kp = jnp.pad(k, pad).reshape(b, g, nq + nb, BAND_BLOCK, d)
    vp = jnp.pad(v, pad).reshape(b, g, nq + nb, BAND_BLOCK, d)
    kband = jnp.concatenate([kp[:, :, j:j + nq] for j in range(nb + 1)], axis=3)
    vband = jnp.concatenate([vp[:, :, j:j + nq] for j in range(nb + 1)], axis=3)
    qb = q.reshape(b, g, r, nq, BAND_BLOCK, d)
    sc = jnp.einsum("bgrnqd,bgnkd->bgrnqk", qb, kband).astype(jnp.float32) * (d ** -0.5)
    blk = jnp.arange(nq)[:, None, None] * BAND_BLOCK
    qpos = blk + jnp.arange(BAND_BLOCK)[None, :, None]
    kpos = blk - window + jnp.arange((nb + 1) * BAND_BLOCK)[None, None, :]
    mask = (kpos <= qpos) & (qpos - kpos < window) & (kpos >= 0)
    sc = jnp.where(mask, sc, NEG)
    if sinks is None:
        p = jax.nn.softmax(sc, axis=-1)
    else:
        sk = sinks.astype(jnp.float32)[None, :, :, None, None, None]
        m = jnp.maximum(jnp.max(sc, axis=-1, keepdims=True), sk)
        e = jnp.exp(sc - m)
        p = e / (jnp.sum(e, axis=-1, keepdims=True) + jnp.exp(sk - m))
    o = jnp.einsum("bgrnqk,bgnkd->bgrnqd", p.astype(v.dtype), vband)
    return o.reshape(b, g, r, s, d)


def compress(k, pe, w1, b1, w2):
    b, g, s, d = k.shape
    ratio = CMP_BLOCK // CMP_STRIDE
    nc = s // CMP_STRIDE - ratio + 1
    chunks = k.reshape(b, g, s // CMP_STRIDE, CMP_STRIDE, d)
    blocks = jnp.concatenate([chunks[:, :, j:j + nc] for j in range(ratio)], axis=3)
    flat = (blocks + pe).reshape(b, g, nc, CMP_BLOCK * d)
    return jax.nn.gelu(flat @ w1 + b1) @ w2


def compressed_attention(q, kc, vc):
    s = q.shape[3]
    nc = kc.shape[2]
    sc = jnp.einsum("bgrsd,bgcd->bgrsc", q, kc).astype(jnp.float32) * (HEAD_DIM ** -0.5)
    c_end = jnp.arange(nc) * CMP_STRIDE + CMP_BLOCK - 1
    valid = c_end[None, :] <= jnp.arange(s)[:, None]
    sc = jnp.where(valid, sc, NEG)
    e = jnp.exp(sc - jnp.max(sc, axis=-1, keepdims=True)) * valid
    p = e / jnp.maximum(jnp.sum(e, axis=-1, keepdims=True), 1e-30)
    o = jnp.einsum("bgrsc,bgcd->bgrsd", p.astype(vc.dtype), vc)
    return o, p


def select_blocks(p_cmp):
    s, nc = p_cmp.shape[3], p_cmp.shape[4]
    nb = s // SLC_BLOCK
    c_start = jnp.arange(nc) * CMP_STRIDE
    s_start = jnp.arange(nb) * SLC_BLOCK
    overlap = ((c_start[:, None] < s_start[None, :] + SLC_BLOCK)
               & (s_start[None, :] < c_start[:, None] + CMP_BLOCK)).astype(jnp.float32)
    imp = jnp.einsum("bgrsc,cj->bgsj", p_cmp, overlap)
    cur = (jnp.arange(s) // SLC_BLOCK)[:, None]
    j = jnp.arange(nb)[None, :]
    forced = (j == 0) | (j == cur) | (j == cur - 1)
    score = jnp.where(forced, BIG, jnp.where(j <= cur, imp, -BIG))
    _, idx = lax.top_k(score, min(SLC_TOP_N, nb))
    return idx


def selected_attention(q, k, v, idx):
    b, g, r, s, d = q.shape
    n = idx.shape[-1]
    nb = s // SLC_BLOCK
    nq = s // SLC_BLOCK
    kb = k.reshape(b, g, nb, SLC_BLOCK, d)
    vb = v.reshape(b, g, nb, SLC_BLOCK, d)
    q_blk = q.reshape(b, g, r, nq, SLC_BLOCK, d).transpose(3, 0, 1, 2, 4, 5)
    i_blk = idx.reshape(b, g, nq, SLC_BLOCK, n).transpose(2, 0, 1, 3, 4)
    starts = jnp.arange(nq) * SLC_BLOCK
    gather = jax.vmap(jax.vmap(lambda blocks, ids: blocks[ids]))

    def one_block(args):
        qb, ib, st = args
        kg = gather(kb, ib).reshape(b, g, SLC_BLOCK, n * SLC_BLOCK, d)
        vg = gather(vb, ib).reshape(b, g, SLC_BLOCK, n * SLC_BLOCK, d)
        kpos = (ib[..., None] * SLC_BLOCK + jnp.arange(SLC_BLOCK)).reshape(b, g, SLC_BLOCK, n * SLC_BLOCK)
        qpos = st + jnp.arange(SLC_BLOCK)
        mask = (kpos <= qpos[None, None, :, None])[:, :, None]
        sc = jnp.einsum("bgrqd,bgqkd->bgrqk", qb, kg).astype(jnp.float32) * (d ** -0.5)
        p = jax.nn.softmax(jnp.where(mask, sc, NEG), axis=-1)
        return jnp.einsum("bgrqk,bgqkd->bgrqd", p.astype(vg.dtype), vg)

    out = lax.map(one_block, (q_blk, i_blk, starts))
    return out.transpose(1, 2, 3, 0, 4, 5).reshape(b, g, r, s, d)


def token_mixer(u, w_in, sinks, cmp_pe_k, cmp_w1_k, cmp_b1_k, cmp_w2_k,
                cmp_pe_v, cmp_w1_v, cmp_b1_v, cmp_w2_v, w_proj_a, w_proj_b, w_out):
    b, s, _ = u.shape
    pos = jnp.arange(s)
    z = u @ w_in
    cuts = [int(c) for c in np.cumsum(SPLIT_SIZES)[:-1]]
    qa, ka, va, qn, kc, vc, ksl, vsl, kw, vw, g_nsa, g_merge = jnp.split(z, cuts, axis=-1)

    qa = rope(heads_q(qa, A_KV_HEADS, A_REP), pos)
    ka = rope(heads_kv(ka, A_KV_HEADS), pos)
    oa = banded_attention(qa, ka, heads_kv(va, A_KV_HEADS), A_WINDOW, sinks.reshape(A_KV_HEADS, A_REP))
    oa = merge_heads(oa)

    qn = heads_q(qn, B_KV_HEADS, B_REP)
    qn_rot = rope(qn, pos)
    kcmp = compress(heads_kv(kc, B_KV_HEADS), cmp_pe_k, cmp_w1_k, cmp_b1_k, cmp_w2_k)
    vcmp = compress(heads_kv(vc, B_KV_HEADS), cmp_pe_v, cmp_w1_v, cmp_b1_v, cmp_w2_v)
    o_cmp, p_cmp = compressed_attention(qn, kcmp, vcmp)
    idx = select_blocks(p_cmp)
    o_slc = selected_attention(qn_rot, rope(heads_kv(ksl, B_KV_HEADS), pos), heads_kv(vsl, B_KV_HEADS), idx)
    o_win = banded_attention(qn_rot, rope(heads_kv(kw, B_KV_HEADS), pos), heads_kv(vw, B_KV_HEADS), B_WINDOW, None)
    gn = jax.nn.sigmoid(g_nsa).reshape(b, s, 3, B_KV_HEADS, B_REP).transpose(2, 0, 3, 4, 1)[..., None]
    ob = merge_heads(gn[0] * o_cmp + gn[1] * o_slc + gn[2] * o_win)

    gm = jax.nn.sigmoid(g_merge).reshape(b, s, 2, D_MODEL)
    y = gm[:, :, 0] * (oa @ w_proj_a) + gm[:, :, 1] * (ob @ w_proj_b)
    return y @ w_out


def setup_inputs(seed: int = 0) -> dict:
    key = jax.random.key(seed)
    ks = jax.random.split(key, 24)
    L = DEPTH

    def nrm(k, shape, scale):
        return jax.random.normal(k, shape, jnp.float32) * scale

    fan_c = CMP_BLOCK * HEAD_DIM
    return {
        "x": nrm(ks[0], (BATCH, SEQ, D_MODEL), 1.0),
        "w_in": nrm(ks[1], (L, D_MODEL, D_IN), D_MODEL ** -0.5),
        "sinks": nrm(ks[2], (L, A_Q_HEADS), 0.5),
        "cmp_pe_k": nrm(ks[3], (L, CMP_BLOCK, HEAD_DIM), 0.1),
        "cmp_w1_k": nrm(ks[4], (L, fan_c, CMP_HIDDEN), fan_c ** -0.5),
        "cmp_b1_k": nrm(ks[5], (L, CMP_HIDDEN), 0.01),
        "cmp_w2_k": nrm(ks[6], (L, CMP_HIDDEN, HEAD_DIM), CMP_HIDDEN ** -0.5),
        "cmp_pe_v": nrm(ks[7], (L, CMP_BLOCK, HEAD_DIM), 0.1),
        "cmp_w1_v": nrm(ks[8], (L, fan_c, CMP_HIDDEN), fan_c ** -0.5),
        "cmp_b1_v": nrm(ks[9], (L, CMP_HIDDEN), 0.01),
        "cmp_w2_v": nrm(ks[10], (L, CMP_HIDDEN, HEAD_DIM), CMP_HIDDEN ** -0.5),
        "w_proj_a": nrm(ks[11], (L, A_Q, D_MODEL), A_Q ** -0.5),
        "w_proj_b": nrm(ks[12], (L, B_Q, D_MODEL), B_Q ** -0.5),
        "w_out": nrm(ks[13], (L, D_MODEL, D_MODEL), BETA * D_MODEL ** -0.5),
        "ln1_g": 1.0 + nrm(ks[14], (L, D_MODEL), 0.01),
        "ln1_b": nrm(ks[15], (L, D_MODEL), 0.01),
        "w_gate": nrm(ks[16], (L, D_MODEL, FFN_HIDDEN), D_MODEL ** -0.5),
        "w_up": nrm(ks[17], (L, D_MODEL, FFN_HIDDEN), D_MODEL ** -0.5),
        "w_down": nrm(ks[18], (L, FFN_HIDDEN, D_MODEL), BETA * FFN_HIDDEN ** -0.5),
        "ln2_g": 1.0 + nrm(ks[19], (L, D_MODEL), 0.01),
        "ln2_b": nrm(ks[20], (L, D_MODEL), 0.01),
    }


def reference(x, w_in, sinks, cmp_pe_k, cmp_w1_k, cmp_b1_k, cmp_w2_k, cmp_pe_v, cmp_w1_v, cmp_b1_v,
              cmp_w2_v, w_proj_a, w_proj_b, w_out, ln1_g, ln1_b, w_gate, w_up, w_down, ln2_g, ln2_b):
    for l in range(DEPTH):
        m = token_mixer(x, w_in[l], sinks[l], cmp_pe_k[l], cmp_w1_k[l], cmp_b1_k[l], cmp_w2_k[l],
                        cmp_pe_v[l], cmp_w1_v[l], cmp_b1_v[l], cmp_w2_v[l], w_proj_a[l], w_proj_b[l], w_out[l])
        h = layer_norm(ALPHA * x + m, ln1_g[l], ln1_b[l])
        f = (jax.nn.silu(h @ w_gate[l]) * (h @ w_up[l])) @ w_down[l]
        x = layer_norm(ALPHA * h + f, ln2_g[l], ln2_b[l])
    return x
```

```cpp
#include <hip/hip_runtime.h>
#include <hip/hip_cooperative_groups.h>
#include <cstdio>
#include <cstdint>
namespace cg = cooperative_groups;
namespace pg8 {
#define PG8_LAS __attribute__((address_space(3)))
typedef unsigned short bf16_t;
typedef short bf16x8 __attribute__((ext_vector_type(8)));
typedef float f32x4 __attribute__((ext_vector_type(4)));
typedef unsigned u32x4 __attribute__((ext_vector_type(4)));
constexpr int BM = 256, BK = 64, HALF = 128, HTB = HALF * BK * 2  , STAGE_BYTES = 8 * HTB, NXCD = 8, WGM = 8;

__host__ __device__ __forceinline__ int lds_byte(int r, int c) { const int st = (r >> 4) * 2 + (c >> 5), rr = r & 15, cc = c & 31, ob = rr * 64 + cc * 2; return st * 1024 + (ob ^ (((ob >> 9) & 1) << 5)); }
__host__ __device__ __forceinline__ void stage_rc(int b, int& R, int& C) { const int st = b / 1024, sb = b % 1024, swz = sb ^ (((sb >> 9) & 1) << 5); R = (st >> 1) * 16 + swz / 64; C = (st & 1) * 32 + (swz % 64) / 2; }
__host__ __device__ __forceinline__ int perm32(int rho) { const int n = rho >> 4, i = rho & 15; return 8 * (i >> 2) + 4 * n + (i & 3); }

struct Unit { int pm, pn; };
struct Gemm { const bf16_t* A; const bf16_t* Bt; int M, N, K, lda; };

struct StaticOrder {
    int nM, nN, nwg, G, c;
    __host__ __device__ void init(int M, int N, int G_, int c_) { nM = M / BM; nN = N / BM; nwg = nM * nN; G = G_; c = c_; }
    __host__ __device__ bool next(int i, Unit& u) const {
        const long L = (long)i * G + c; if (L >= nwg) return false;
        int wgid = (int)L; { const int q = nwg / NXCD, r = nwg % NXCD, xcd = wgid % NXCD, off = wgid / NXCD; wgid = (xcd < r ? xcd * (q + 1) : r * (q + 1) + (xcd - r) * q) + off; }
        const int nig = WGM * nN, gid = wgid / nig, fm = gid * WGM, gsz = (nM - fm) < WGM ? (nM - fm) : WGM;
        u.pm = fm + ((wgid % nig) % gsz); u.pn = (wgid % nig) / gsz; return true;
    }
    __device__ __forceinline__ void a_ready(const Unit&) const {}
    __device__ __forceinline__ void done(const Unit&) const {}
};

__device__ __forceinline__ unsigned cvt_pk_bf16(float lo, float hi) { unsigned r; asm volatile("v_cvt_pk_bf16_f32 %0, %1, %2" : "=v"(r) : "v"(lo), "v"(hi)); return r; }
template <class Epi, class Sched, bool ALIGN_EPI = false, bool SP2 = false>
__device__ __forceinline__ void gemm_phase(PG8_LAS unsigned char* lds, const Gemm g, const Sched& S, const Epi& E) {
    int tid = threadIdx.x; asm volatile("" : "+v"(tid));
    const int wid = __builtin_amdgcn_readfirstlane(tid >> 6), lane = tid & 63, wr = wid >> 2, wc = wid & 3, fr = lane & 15, fq = lane >> 4;
    const int K = g.K, lda = g.lda, nt = K / BK;
    unsigned voffA[2], voffB[2];
#pragma unroll
    for (int i = 0; i < 2; ++i) { int R, C; stage_rc(tid * 16 + i * 8192, R, C); const int Rb = Epi::PERM ? ((R & ~31) + perm32(R & 31)) : R;
        voffA[i] = (unsigned)(R * lda + C) * 2u; voffB[i] = (unsigned)(Rb * K + C) * 2u; }
    const size_t kstep = (size_t)(BK * 2);
    const size_t hstepB = (size_t)HALF * K * 2, hstepA = (size_t)HALF * lda * 2;
    const size_t tstepB = 2 * hstepB, tstepA = 2 * hstepA;
    const unsigned ldsw = (unsigned)wid * 1024u;
    const int aoff = lds_byte(wr * 64 + fr, fq * 8), boff = lds_byte(wc * 32 + fr, fq * 8);
#define PG8_SA(b, h) (((b) * 2 + (h)) * HTB)
#define PG8_SB(b, h) ((4 + (b) * 2 + (h)) * HTB)
#define PG8_STAGE(bufoff, gbase, voff) do { _Pragma("unroll") for (int _i = 0; _i < 2; ++_i) \
        __builtin_amdgcn_global_load_lds((const unsigned*)((const char*)(gbase) + (voff)[_i]), (PG8_LAS unsigned*)(lds + (bufoff) + ldsw + _i * 8192), 16, 0, 0); } while (0)
#define PG8_LDA(dst, b, h) do { _Pragma("unroll") for (int m = 0; m < 4; ++m) _Pragma("unroll") for (int k = 0; k < 2; ++k) dst[m][k] = *(const PG8_LAS bf16x8*)(lds + PG8_SA(b, h) + aoff + m * 2048 + k * 1024); } while (0)
#define PG8_LDB(dst, b, h) do { _Pragma("unroll") for (int n = 0; n < 2; ++n) _Pragma("unroll") for (int k = 0; k < 2; ++k) dst[n][k] = *(const PG8_LAS bf16x8*)(lds + PG8_SB(b, h) + boff + n * 2048 + k * 1024); } while (0)
#define PG8_MMA(ai, bj, At, Bt) do { __builtin_amdgcn_s_setprio(1); _Pragma("unroll") for (int m = 0; m < 4; ++m) _Pragma("unroll") for (int n = 0; n < 2; ++n) _Pragma("unroll") for (int k = 0; k < 2; ++k) \
        acc[ai][bj][m][n] = __builtin_amdgcn_mfma_f32_16x16x32_bf16(Bt[n][k], At[m][k], acc[ai][bj][m][n], 0, 0, 0); __builtin_amdgcn_s_setprio(0); } while (0)
#define PG8_WAIT_V(n) asm volatile("s_waitcnt vmcnt(" #n ")" ::: "memory")
#define PG8_WAIT_L(n) asm volatile("s_waitcnt lgkmcnt(" #n ")" ::: "memory")
#define PG8_BAR __builtin_amdgcn_s_barrier()
#define PG8_SCHED __builtin_amdgcn_sched_barrier(0)
    Unit cur, nxt; int ui = 0;
    if (!S.next(0, cur)) return;
    f32x4 acc[2][2][4][2];
#pragma unroll
    for (int a = 0; a < 2; ++a)
#pragma unroll
        for (int b = 0; b < 2; ++b)
#pragma unroll
            for (int m = 0; m < 4; ++m)
#pragma unroll
                for (int n = 0; n < 2; ++n) acc[a][b][m][n] = (f32x4){0.f, 0.f, 0.f, 0.f};
    bf16x8 At[4][2], B0[2][2], B1[2][2];
    const char* cA = (const char*)g.A + (size_t)cur.pm * tstepA; const char* cB = (const char*)g.Bt + (size_t)cur.pn * tstepB;
    S.a_ready(cur);
    if constexpr (SP2) {
        PG8_STAGE(PG8_SB(0, 0), cB, voffB); PG8_STAGE(PG8_SB(0, 1), cB + hstepB, voffB); PG8_STAGE(PG8_SA(0, 0), cA, voffA); PG8_STAGE(PG8_SA(0, 1), cA + hstepA, voffA);
        if (wr == 1) PG8_BAR;
        PG8_WAIT_V(2); PG8_BAR;
        PG8_STAGE(PG8_SB(1, 0), cB + kstep, voffB); PG8_STAGE(PG8_SA(1, 0), cA + kstep, voffA); PG8_STAGE(PG8_SB(1, 1), cB + hstepB + kstep, voffB);
        PG8_WAIT_V(6); PG8_BAR;
    } else {
        PG8_STAGE(PG8_SB(0, 0), cB, voffB); PG8_STAGE(PG8_SA(0, 0), cA, voffA); PG8_STAGE(PG8_SB(0, 1), cB + hstepB, voffB); PG8_STAGE(PG8_SA(0, 1), cA + hstepA, voffA);
        if (wr == 1) PG8_BAR;
        PG8_WAIT_V(4); PG8_BAR;
        PG8_STAGE(PG8_SB(1, 0), cB + kstep, voffB); PG8_STAGE(PG8_SA(1, 0), cA + kstep, voffA); PG8_STAGE(PG8_SB(1, 1), cB + hstepB + kstep, voffB);
        PG8_WAIT_V(6); PG8_BAR;
    }
    for (;;) {
        const bool has_next = S.next(ui + 1, nxt);
        const char* nA = has_next ? (const char*)g.A + (size_t)nxt.pm * tstepA : cA; const char* nB = has_next ? (const char*)g.Bt + (size_t)nxt.pn * tstepB : cB;
        for (int t = 0; t < nt; t += 2) {
            const bool last = (t == nt - 2);
            const char* a1 = cA + (size_t)(t + 1) * kstep;
            const char* a2 = last ? nA : cA + (size_t)(t + 2) * kstep; const char* b2 = last ? nB : cB + (size_t)(t + 2) * kstep;
            const char* a3 = a2 + kstep; const char* b3 = b2 + kstep;
            if (last && has_next) S.a_ready(nxt);
            if constexpr (SP2) {
            PG8_LDB(B0, 0, 0); PG8_LDB(B1, 0, 1); PG8_SCHED; PG8_LDA(At, 0, 0); PG8_STAGE(PG8_SA(1, 1), a1 + hstepA, voffA);
            PG8_WAIT_V(8); PG8_WAIT_L(0); PG8_BAR; PG8_MMA(0, 0, At, B0); PG8_MMA(0, 1, At, B1); PG8_BAR; PG8_SCHED;
            PG8_LDA(At, 0, 1); PG8_STAGE(PG8_SB(0, 0), b2, voffB); PG8_STAGE(PG8_SB(0, 1), b2 + hstepB, voffB); PG8_STAGE(PG8_SA(0, 0), a2, voffA);
            PG8_WAIT_V(8); PG8_WAIT_L(0); PG8_BAR; PG8_MMA(1, 0, At, B0); PG8_MMA(1, 1, At, B1); PG8_BAR; PG8_SCHED;
            PG8_LDB(B0, 1, 0); PG8_LDB(B1, 1, 1); PG8_SCHED; PG8_LDA(At, 1, 0); PG8_STAGE(PG8_SA(0, 1), a2 + hstepA, voffA);
            PG8_WAIT_V(8); PG8_WAIT_L(0); PG8_BAR; PG8_MMA(0, 0, At, B0); PG8_MMA(0, 1, At, B1); PG8_BAR; PG8_SCHED;
            PG8_LDA(At, 1, 1); PG8_STAGE(PG8_SB(1, 0), b3, voffB); PG8_STAGE(PG8_SB(1, 1), b3 + hstepB, voffB); PG8_STAGE(PG8_SA(1, 0), a3, voffA);
            PG8_WAIT_V(8); PG8_WAIT_L(0); PG8_BAR; PG8_MMA(1, 0, At, B0); PG8_MMA(1, 1, At, B1); PG8_BAR; PG8_SCHED;
            } else {
            PG8_LDB(B0, 0, 0); PG8_SCHED; PG8_LDA(At, 0, 0); PG8_STAGE(PG8_SA(1, 1), a1 + hstepA, voffA);
            PG8_WAIT_L(8); PG8_BAR; PG8_WAIT_L(0); PG8_MMA(0, 0, At, B0); PG8_BAR; PG8_SCHED;
            PG8_LDB(B1, 0, 1); PG8_STAGE(PG8_SB(0, 0), b2, voffB);
            PG8_BAR; PG8_WAIT_L(0); PG8_MMA(0, 1, At, B1); PG8_BAR;
            PG8_LDA(At, 0, 1); PG8_STAGE(PG8_SA(0, 0), a2, voffA);
            PG8_BAR; PG8_WAIT_L(0); PG8_MMA(1, 0, At, B0); PG8_BAR; PG8_SCHED;
            PG8_STAGE(PG8_SB(0, 1), b2 + hstepB, voffB);
            PG8_WAIT_V(6); PG8_BAR; PG8_MMA(1, 1, At, B1); PG8_BAR;
            PG8_LDB(B0, 1, 0); PG8_SCHED; PG8_LDA(At, 1, 0); PG8_STAGE(PG8_SA(0, 1), a2 + hstepA, voffA);
            PG8_WAIT_L(8); PG8_BAR; PG8_WAIT_L(0); PG8_MMA(0, 0, At, B0); PG8_BAR; PG8_SCHED;
            PG8_LDB(B1, 1, 1); PG8_STAGE(PG8_SB(1, 0), b3, voffB);
            PG8_BAR; PG8_WAIT_L(0); PG8_MMA(0, 1, At, B1); PG8_BAR;
            PG8_LDA(At, 1, 1); PG8_STAGE(PG8_SA(1, 0), a3, voffA);
            PG8_BAR; PG8_WAIT_L(0); PG8_MMA(1, 0, At, B0); PG8_BAR; PG8_SCHED;
            PG8_STAGE(PG8_SB(1, 1), b3 + hstepB, voffB);
            PG8_WAIT_V(6); PG8_BAR; PG8_MMA(1, 1, At, B1); PG8_BAR;
            }
        }
        if constexpr (ALIGN_EPI) { if (wr == 0) PG8_BAR; }
        if constexpr (!Epi::AFTER_DRAIN) { E(acc, cur, wr, wc, fr, fq); S.done(cur); }
        if (!has_next) break;
#pragma unroll
        for (int a = 0; a < 2; ++a)
#pragma unroll
            for (int b = 0; b < 2; ++b)
#pragma unroll
                for (int m = 0; m < 4; ++m)
#pragma unroll
                    for (int n = 0; n < 2; ++n) acc[a][b][m][n] = (f32x4){0.f, 0.f, 0.f, 0.f};
        cur = nxt; cA = nA; cB = nB; ++ui;
        if constexpr (ALIGN_EPI) { if (wr == 1) PG8_BAR; }
    }
    PG8_WAIT_V(0);
    if constexpr (!ALIGN_EPI) { if (wr == 0) PG8_BAR; }
    PG8_BAR;
    if constexpr (Epi::AFTER_DRAIN) { E.fused(acc, cur, wr, wc, fr, fq, lds, wid, lane); S.done(cur); }
#undef PG8_SA
#undef PG8_SB
#undef PG8_STAGE
#undef PG8_LDA
#undef PG8_LDB
#undef PG8_MMA
#undef PG8_WAIT_V
#undef PG8_WAIT_L
#undef PG8_BAR
#undef PG8_SCHED
}
}

namespace mk {
#define LAS __attribute__((address_space(3)))
using pg8::bf16_t; using pg8::Unit; using pg8::cvt_pk_bf16;
typedef short bf16x8 __attribute__((ext_vector_type(8)));
typedef short s16x4 __attribute__((ext_vector_type(4)));
typedef float f32x4 __attribute__((ext_vector_type(4)));
typedef float f32x16 __attribute__((ext_vector_type(16)));
typedef unsigned u32x4 __attribute__((ext_vector_type(4)));
typedef unsigned u32x2 __attribute__((ext_vector_type(2)));
typedef float f32x2_t __attribute__((ext_vector_type(2)));
typedef __bf16 bf16x2_t __attribute__((ext_vector_type(2)));

constexpr int T = 65536, SEQ = 2048, D = 1024, DIN = 4120, DINP = 4352, FF = 2816, NGU = 5632;
constexpr float ALPHA = 1.189207115002721f;
constexpr float LN_EPS = 1e-5f;
constexpr float LOG2E = 1.4426950408889634f;
constexpr float QSCALE = 0.125f * LOG2E;
constexpr int NTHREADS = 512, NWAVES = 8;
constexpr int LDS_BYTES = 147456;

constexpr size_t KiB = 1024, MiB = 1u << 20;
constexpr size_t WS_CTL = 0, WS_CPART = 64 * KiB, WS_CBIAS = 256 * KiB, WS_ROPE = 512 * KiB;
constexpr size_t WS_WIN = 1 * MiB, WS_WPA = 10 * MiB, WS_WPB = 11 * MiB, WS_WOUT = 12 * MiB, WS_WGU = 14 * MiB, WS_WDN = 25 * MiB;
constexpr size_t WS_CW1K = 31 * MiB, WS_CW1V = 32 * MiB, WS_CW2K = 33 * MiB, WS_CW2V = 33 * MiB + 512 * KiB;
constexpr size_t WS_H1K = 35 * MiB, WS_H1V = 39 * MiB, WS_KCMP = 43 * MiB, WS_VCMPT = 44 * MiB, WS_GN = 45 * MiB;
constexpr size_t WS_XB = 64 * MiB, WS_OA = 64 * MiB, WS_OB = 128 * MiB;
constexpr size_t WS_QA = 192 * MiB, WS_QN = 256 * MiB, WS_QNR = 320 * MiB;
constexpr size_t WS_KA = 384 * MiB, WS_VAT = 400 * MiB, WS_KC = 416 * MiB, WS_VC = 432 * MiB, WS_KSL = 448 * MiB, WS_VSLT = 464 * MiB, WS_KW = 480 * MiB, WS_VWT = 496 * MiB;
constexpr size_t WS_GM = 512 * MiB;
constexpr size_t WS_T1 = 192 * MiB, WS_Y = 320 * MiB, WS_PRE1 = 512 * MiB, WS_HF = 64 * MiB, WS_HB = 320 * MiB, WS_ACT = 448 * MiB;
constexpr size_t WS_END = 800 * MiB;

struct Params {
    const float *x, *w_in, *sinks, *pe_k, *w1_k, *b1_k, *w2_k, *pe_v, *w1_v, *b1_v, *w2_v, *wpa, *wpb, *wout, *ln1g, *ln1b, *wg, *wu, *wd, *ln2g, *ln2b;
    float* out; unsigned char* ws;
};

__device__ __forceinline__ unsigned f2bf(float f) { unsigned u = __builtin_bit_cast(unsigned, f); return (u + 0x7fffu + ((u >> 16) & 1u)) >> 16; }
__device__ __forceinline__ unsigned pk2(float lo, float hi) { f32x2_t v = {lo, hi}; bf16x2_t b = __builtin_convertvector(v, bf16x2_t); return __builtin_bit_cast(unsigned, b); }
__device__ __forceinline__ float bflo(unsigned w) { return __builtin_bit_cast(float, w << 16); }
__device__ __forceinline__ float bfhi(unsigned w) { return __builtin_bit_cast(float, w & 0xffff0000u); }
__device__ __forceinline__ float sigmoidf_(float x) { return __builtin_amdgcn_rcpf(1.f + __builtin_amdgcn_exp2f(-x * LOG2E)); }
__device__ __forceinline__ int dmap(int q) { const int i = q & 7, j = q >> 3; return (i < 4) ? (4 * j + i) : (32 + 4 * j + (i - 4)); }

__device__ __forceinline__ int win_src(int p) {
    if (p < 2048) {
        const bool il = (p < 640) || (p >= 768 && p < 1280) || (p >= 1536 && p < 1664) || (p >= 1792 && p < 1920);
        return il ? ((p & ~63) + dmap(p & 63)) : p;
    }
    if (p < 4096) return 2072 + (p - 2048);
    if (p < 4120) return 2048 + (p - 4096);
    return -1;
}

struct WinCols { const float* w; __device__ __forceinline__ const float* operator()(int p) const { const int s = win_src(p); return s < 0 ? nullptr : w + s; } };
struct IdCols { const float* w; __device__ __forceinline__ const float* operator()(int p) const { return w + p; } };
struct GuCols { const float *wg, *wu; __device__ __forceinline__ const float* operator()(int p) const { const int q = p >> 3, i = p & 7; const uintptr_t a = (uintptr_t)wg, b = (uintptr_t)wu; const uintptr_t sel = a ^ ((a ^ b) & (uintptr_t)(-(long long)(i >= 4))); return (const float*)sel + 4 * q + (i & 3); } };
struct Cw2kCols { const float* w; __device__ __forceinline__ const float* operator()(int p) const { return p < 64 ? w + dmap(p) : nullptr; } };
struct Cw2vCols { const float* w; __device__ __forceinline__ const float* operator()(int p) const { return p < 64 ? w + p : nullptr; } };

template <class F> __device__ __forceinline__ void transpose_item(const F& colfn, int ldw, int K, int nblk, bf16_t* WT, LAS float* scr, int item, int lane) {
    const int kb = item / nblk, nb = item % nblk, k0 = 64 * kb, n0 = 32 * nb;
    const float* cp = colfn(n0 + (lane & 31));
#pragma unroll 8
    for (int i = 0; i < 32; ++i) { const int kk = 2 * i + (lane >> 5); scr[kk * 33 + (lane & 31)] = cp ? cp[(size_t)(k0 + kk) * ldw] : 0.f; }
    asm volatile("s_waitcnt lgkmcnt(0)" ::: "memory");
    const int c = lane & 7;
#pragma unroll
    for (int j = 0; j < 4; ++j) { const int n = (lane >> 3) + 8 * j; const LAS float* s = scr + (8 * c) * 33 + n;
        u32x4 o; o.x = pk2(s[0 * 33], s[1 * 33]); o.y = pk2(s[2 * 33], s[3 * 33]); o.z = pk2(s[4 * 33], s[5 * 33]); o.w = pk2(s[6 * 33], s[7 * 33]);
        *(u32x4*)(WT + (size_t)(n0 + n) * K + k0 + 8 * c) = o; }
    asm volatile("s_waitcnt lgkmcnt(0)" ::: "memory");
}

__device__ __forceinline__ void p0_prologue(const Params& P, LAS unsigned char* lds, int tid, int lane, int wave) {
    unsigned char* ws = P.ws;
    LAS float* scr = (LAS float*)(lds + wave * 16384);
    const int gw = blockIdx.x * NWAVES + wave, NGW = gridDim.x * NWAVES;
    if (blockIdx.x == 0 && tid < 256) ((unsigned*)(ws + WS_CTL))[tid] = 0u;
    constexpr int I_IN = 16 * (DINP / 32), I_PA = 8 * 32, I_PB = 8 * 32, I_OUT = 16 * 32, I_GU = 16 * (NGU / 32), I_DN = (FF / 64) * 32, I_C1 = 32 * 8, I_C2 = 4 * 8;
    constexpr int NITEMS = I_IN + I_PA + I_PB + I_OUT + I_GU + I_DN + 2 * I_C1 + 2 * I_C2;
    for (int it = gw; it < NITEMS; it += NGW) {
        int r = it;
        if (r < I_IN) { transpose_item(WinCols{P.w_in}, DIN, 1024, DINP / 32, (bf16_t*)(ws + WS_WIN), scr, r, lane); continue; } r -= I_IN;
        if (r < I_PA) { transpose_item(IdCols{P.wpa}, 1024, 512, 32, (bf16_t*)(ws + WS_WPA), scr, r, lane); continue; } r -= I_PA;
        if (r < I_PB) { transpose_item(IdCols{P.wpb}, 1024, 512, 32, (bf16_t*)(ws + WS_WPB), scr, r, lane); continue; } r -= I_PB;
        if (r < I_OUT) { transpose_item(IdCols{P.wout}, 1024, 1024, 32, (bf16_t*)(ws + WS_WOUT), scr, r, lane); continue; } r -= I_OUT;
        if (r < I_GU) { transpose_item(GuCols{P.wg, P.wu}, FF, 1024, NGU / 32, (bf16_t*)(ws + WS_WGU), scr, r, lane); continue; } r -= I_GU;
        if (r < I_DN) { transpose_item(IdCols{P.wd}, 1024, FF, 32, (bf16_t*)(ws + WS_WDN), scr, r, lane); continue; } r -= I_DN;
        if (r < I_C1) { transpose_item(IdCols{P.w1_k}, 256, 2048, 8, (bf16_t*)(ws + WS_CW1K), scr, r, lane); continue; } r -= I_C1;
        if (r < I_C1) { transpose_item(IdCols{P.w1_v}, 256, 2048, 8, (bf16_t*)(ws + WS_CW1V), scr, r, lane); continue; } r -= I_C1;
        if (r < I_C2) { transpose_item(Cw2kCols{P.w2_k}, 64, 256, 8, (bf16_t*)(ws + WS_CW2K), scr, r, lane); continue; } r -= I_C2;
        transpose_item(Cw2vCols{P.w2_v}, 64, 256, 8, (bf16_t*)(ws + WS_CW2V), scr, r, lane);
    }
    {
        float* rc = (float*)(ws + WS_ROPE); float* rs = rc + 2048 * 32;
        for (int e = blockIdx.x * NTHREADS + tid; e < 2048 * 32; e += gridDim.x * NTHREADS) {
            const int pos = e >> 5, j = e & 31;
            const float invf = (float)exp(-(double)j * (9.210340371976184 / 32.0));
            const float ang = (float)pos * invf;
            rc[e] = (float)cos((double)ang); rs[e] = (float)sin((double)ang);
        }
    }
    if (blockIdx.x < 128 && tid < 256) {
        const int which = blockIdx.x >> 6, kc = blockIdx.x & 63, n = tid;
        const float* pe = which ? P.pe_v : P.pe_k; const float* w1 = which ? P.w1_v : P.w1_k;
        float s = 0.f;
#pragma unroll 8
        for (int i = 0; i < 32; ++i) { const int k = kc * 32 + i; s += pe[k] * w1[(size_t)k * 256 + n]; }
        ((float*)(ws + WS_CPART))[(which * 64 + kc) * 256 + n] = s;
    }
    for (int m = gw; m < T; m += NGW) {
        const f32x4* xr = (const f32x4*)(P.x + (size_t)m * D) + lane;
        u32x2* o8 = (u32x2*)((bf16_t*)(ws + WS_XB) + (size_t)m * D) + lane;
#pragma unroll
        for (int j = 0; j < 4; ++j) { const f32x4 v = xr[64 * j]; u32x2 o; o.x = pk2(v.x, v.y); o.y = pk2(v.z, v.w); o8[64 * j] = o; }
    }
}

struct EpiZ {
    static constexpr bool PERM = true, AFTER_DRAIN = false;
    unsigned char* ws;
    template <int MODE, int BJ> __device__ __forceinline__ void half(const f32x4 (&acc)[2][2][4][2], int sec, int row0, int wc, int fq) const {
        const int cb = sec * 128 + wc * 32 + 8 * fq;
        const int hc = cb & 63, j0 = (hc >> 3) * 4, g = (cb & 127) >> 6;
        size_t woff;
        if (MODE == 0) woff = WS_QA; else if (MODE == 1) woff = WS_QN;
        else if (MODE == 2) woff = sec == 4 ? WS_KA : (sec == 12 ? WS_KSL : WS_KW);
        else if (MODE == 3) woff = sec == 10 ? WS_KC : WS_VC;
        else if (MODE == 4) woff = sec == 5 ? WS_VAT : (sec == 13 ? WS_VSLT : WS_VWT);
        else if (MODE == 5) woff = WS_GM; else woff = WS_GN;
        bf16_t* dst = (bf16_t*)(ws + woff);
        const float* rc = (const float*)(ws + WS_ROPE); const float* rs = rc + 2048 * 32;
#pragma unroll
        for (int ai = 0; ai < 2; ++ai)
#pragma unroll
            for (int m = 0; m < 4; ++m) {
                const int row = row0 + ai * 128 + m * 16, pos = row & 2047, bgi = (row >> 11) * 2 + g;
                const f32x4 v0 = acc[ai][BJ][m][0], v1 = acc[ai][BJ][m][1];
                if (MODE <= 2) {
                    const f32x4 c = *(const f32x4*)(rc + pos * 32 + j0), s = *(const f32x4*)(rs + pos * 32 + j0);
                    f32x4 o1 = v0 * c - v1 * s, o2 = v1 * c + v0 * s;
                    if (MODE == 2) {
                        u32x4 w; w.x = pk2(o1[0], o1[1]); w.y = pk2(o1[2], o1[3]); w.z = pk2(o2[0], o2[1]); w.w = pk2(o2[2], o2[3]);
                        *(u32x4*)(dst + ((size_t)bgi * 2048 + pos) * 64 + hc) = w;
                    } else {
                        o1 = o1 * QSCALE; o2 = o2 * QSCALE;
                        u32x4 w; w.x = pk2(o1[0], o1[1]); w.y = pk2(o1[2], o1[3]); w.z = pk2(o2[0], o2[1]); w.w = pk2(o2[2], o2[3]);
                        if (MODE == 0) *(u32x4*)(dst + (size_t)row * 512 + cb) = w;
                        else {
                            *(u32x4*)(dst + (WS_QNR - WS_QN) / 2 + (size_t)row * 512 + (cb - 768)) = w;
                            const f32x4 a = v0 * QSCALE, b = v1 * QSCALE;
                            u32x4 w2; w2.x = pk2(a[0], a[1]); w2.y = pk2(a[2], a[3]); w2.z = pk2(b[0], b[1]); w2.w = pk2(b[2], b[3]);
                            *(u32x4*)(dst + (size_t)row * 512 + (cb - 768)) = w2;
                        }
                    }
                } else if (MODE == 3) {
                    u32x4 w; w.x = pk2(v0[0], v0[1]); w.y = pk2(v0[2], v0[3]); w.z = pk2(v1[0], v1[1]); w.w = pk2(v1[2], v1[3]);
                    *(u32x4*)(dst + ((size_t)bgi * 2048 + pos) * 64 + hc) = w;
                } else if (MODE == 4) {
                    bf16_t* p = dst + ((size_t)bgi * 64 + hc) * 2048 + pos;
#pragma unroll
                    for (int i = 0; i < 4; ++i) { p[(size_t)i * 2048] = (bf16_t)f2bf(v0[i]); p[(size_t)(4 + i) * 2048] = (bf16_t)f2bf(v1[i]); }
                } else {
                    f32x4 a, b;
#pragma unroll
                    for (int i = 0; i < 4; ++i) { a[i] = sigmoidf_(v0[i]); b[i] = sigmoidf_(v1[i]); }
                    u32x4 w; w.x = pk2(a[0], a[1]); w.y = pk2(a[2], a[3]); w.z = pk2(b[0], b[1]); w.w = pk2(b[2], b[3]);
                    if (MODE == 5) *(u32x4*)(dst + (size_t)row * 2048 + (cb - 2048)) = w;
                    else if (wc == 0) *(u32x4*)(dst + (size_t)row * 32 + 8 * fq) = w;
                }
            }
    }
    __device__ __forceinline__ void operator()(const f32x4 (&acc)[2][2][4][2], const Unit& u, int wr, int wc, int fr, int fq) const {
        const int row0 = u.pm * 256 + wr * 64 + fr;
        both<0>(acc, u.pn * 2, row0, wc, fq); both<1>(acc, u.pn * 2 + 1, row0, wc, fq);
    }
    template <int BJ> __device__ __forceinline__ void both(const f32x4 (&acc)[2][2][4][2], int sec, int row0, int wc, int fq) const {
        if (sec < 4) half<0, BJ>(acc, sec, row0, wc, fq);
        else if (sec == 4 || sec == 12 || sec == 14) half<2, BJ>(acc, sec, row0, wc, fq);
        else if (sec == 5 || sec == 13 || sec == 15) half<4, BJ>(acc, sec, row0, wc, fq);
        else if (sec < 10) half<1, BJ>(acc, sec, row0, wc, fq);
        else if (sec < 12) half<3, BJ>(acc, sec, row0, wc, fq);
        else if (sec < 32) half<5, BJ>(acc, sec, row0, wc, fq);
        else if (sec == 32) half<6, BJ>(acc, sec, row0, wc, fq);
    }
};

struct EpiC1 {
    static constexpr bool PERM = true, AFTER_DRAIN = false;
    bf16_t* O; const float* bias;
    __device__ __forceinline__ void operator()(const f32x4 (&acc)[2][2][4][2], const Unit& u, int wr, int wc, int fr, int fq) const {
        const int row0 = u.pm * 256 + wr * 64 + fr;
#pragma unroll
        for (int bj = 0; bj < 2; ++bj) {
            const int col = bj * 128 + wc * 32 + 8 * fq;
            const f32x4 b0 = *(const f32x4*)(bias + col), b1 = *(const f32x4*)(bias + col + 4);
#pragma unroll
            for (int ai = 0; ai < 2; ++ai)
#pragma unroll
                for (int m = 0; m < 4; ++m) {
                    const int row = row0 + ai * 128 + m * 16;
                    f32x4 v0 = acc[ai][bj][m][0] + b0, v1 = acc[ai][bj][m][1] + b1;
#pragma unroll
                    for (int i = 0; i < 4; ++i) {
                        { const float x = v0[i], uu = 0.7978845608028654f * (x + 0.044715f * x * x * x); v0[i] = x * sigmoidf_(2.f * uu); }
                        { const float x = v1[i], uu = 0.7978845608028654f * (x + 0.044715f * x * x * x); v1[i] = x * sigmoidf_(2.f * uu); }
                    }
                    u32x4 w; w.x = pk2(v0[0], v0[1]); w.y = pk2(v0[2], v0[3]); w.z = pk2(v1[0], v1[1]); w.w = pk2(v1[2], v1[3]);
                    *(u32x4*)(O + (size_t)row * 256 + col) = w;
                }
        }
    }
};
struct EpiC2 {
    static constexpr bool PERM = true, AFTER_DRAIN = false;
    bf16_t* O; int transposed;
    __device__ __forceinline__ void operator()(const f32x4 (&acc)[2][2][4][2], const Unit& u, int wr, int wc, int fr, int fq) const {
        if (wc >= 2) return;
        const int row0 = u.pm * 256 + wr * 64 + fr, col = wc * 32 + 8 * fq;
#pragma unroll
        for (int ai = 0; ai < 2; ++ai)
#pragma unroll
            for (int m = 0; m < 4; ++m) {
                const int row = row0 + ai * 128 + m * 16;
                const f32x4 v0 = acc[ai][0][m][0], v1 = acc[ai][0][m][1];
                if (!transposed) {
                    u32x4 w; w.x = pk2(v0[0], v0[1]); w.y = pk2(v0[2], v0[3]); w.z = pk2(v1[0], v1[1]); w.w = pk2(v1[2], v1[3]);
                    *(u32x4*)(O + (size_t)row * 64 + col) = w;
                } else {
                    bf16_t* p = O + ((size_t)(row >> 7) * 64 + col) * 128 + (row & 127);
#pragma unroll
                    for (int i = 0; i < 4; ++i) { p[i * 128] = (bf16_t)f2bf(v0[i]); p[(4 + i) * 128] = (bf16_t)f2bf(v1[i]); }
                }
            }
    }
};
template <bool SECOND> struct EpiProj {
    static constexpr bool PERM = true, AFTER_DRAIN = false;
    const bf16_t* gm; const bf16_t* t1; bf16_t* O;
    __device__ __forceinline__ void operator()(const f32x4 (&acc)[2][2][4][2], const Unit& u, int wr, int wc, int fr, int fq) const {
        const int row0 = u.pm * 256 + wr * 64 + fr;
#pragma unroll
        for (int bj = 0; bj < 2; ++bj) {
            const int col = u.pn * 256 + bj * 128 + wc * 32 + 8 * fq;
#pragma unroll
            for (int ai = 0; ai < 2; ++ai)
#pragma unroll
                for (int m = 0; m < 4; ++m) {
                    const size_t row = (size_t)(row0 + ai * 128 + m * 16);
                    const u32x4 gw = *(const u32x4*)(gm + row * 2048 + (SECOND ? 1024 : 0) + col);
                    const f32x4 v0 = acc[ai][bj][m][0], v1 = acc[ai][bj][m][1];
                    float r[8] = {v0[0] * bflo(gw.x), v0[1] * bfhi(gw.x), v0[2] * bflo(gw.y), v0[3] * bfhi(gw.y), v1[0] * bflo(gw.z), v1[1] * bfhi(gw.z), v1[2] * bflo(gw.w), v1[3] * bfhi(gw.w)};
                    if (SECOND) {
                        const u32x4 tw = *(const u32x4*)(t1 + row * 1024 + col);
                        r[0] += bflo(tw.x); r[1] += bfhi(tw.x); r[2] += bflo(tw.y); r[3] += bfhi(tw.y); r[4] += bflo(tw.z); r[5] += bfhi(tw.z); r[6] += bflo(tw.w); r[7] += bfhi(tw.w);
                    }
                    u32x4 w; w.x = pk2(r[0], r[1]); w.y = pk2(r[2], r[3]); w.z = pk2(r[4], r[5]); w.w = pk2(r[6], r[7]);
                    *(u32x4*)(O + row * 1024 + col) = w;
                }
        }
    }
};
struct EpiRes {
    static constexpr bool PERM = false, AFTER_DRAIN = false;
    const float* base; float* out;
    __device__ __forceinline__ void operator()(const f32x4 (&acc)[2][2][4][2], const Unit& u, int wr, int wc, int fr, int fq) const {
        const int row0 = u.pm * 256 + wr * 64 + fr, col0 = u.pn * 256 + wc * 32 + 4 * fq;
#pragma unroll
        for (int ai = 0; ai < 2; ++ai)
#pragma unroll
            for (int m = 0; m < 4; ++m) {
                const size_t off = (size_t)(row0 + ai * 128 + m * 16) * 1024 + col0;
#pragma unroll
                for (int bj = 0; bj < 2; ++bj)
#pragma unroll
                    for (int n = 0; n < 2; ++n) { const f32x4 b = *(const f32x4*)(base + off + bj * 128 + n * 16); *(f32x4*)(out + off + bj * 128 + n * 16) = b * ALPHA + acc[ai][bj][m][n]; }
            }
    }
};
struct EpiGU {
    static constexpr bool PERM = true, AFTER_DRAIN = false;
    bf16_t* O;
    __device__ __forceinline__ void operator()(const f32x4 (&acc)[2][2][4][2], const Unit& u, int wr, int wc, int fr, int fq) const {
        const int row0 = u.pm * 256 + wr * 64 + fr;
#pragma unroll
        for (int bj = 0; bj < 2; ++bj) {
            const int hcol = (u.pn * 256 + bj * 128 + wc * 32 + 8 * fq) >> 1;
#pragma unroll
            for (int ai = 0; ai < 2; ++ai)
#pragma unroll
                for (int m = 0; m < 4; ++m) {
                    const size_t row = (size_t)(row0 + ai * 128 + m * 16);
                    const f32x4 g = acc[ai][bj][m][0], up = acc[ai][bj][m][1];
                    float a[4];
#pragma unroll
                    for (int i = 0; i < 4; ++i) a[i] = g[i] * sigmoidf_(g[i]) * up[i];
                    u32x2 w; w.x = pk2(a[0], a[1]); w.y = pk2(a[2], a[3]);
                    *(u32x2*)(O + row * FF + hcol) = w;
                }
        }
    }
};

template <bool WRITE_BF> __device__ __forceinline__ void ln_phase(const float* in, float* outf, bf16_t* outb, const float* gam, const float* bet, int lane, int wave) {
    const int gw = blockIdx.x * NWAVES + wave, NGW = gridDim.x * NWAVES;
    f32x4 gv[4], bv[4];
#pragma unroll
    for (int j = 0; j < 4; ++j) { gv[j] = ((const f32x4*)gam)[lane + 64 * j]; bv[j] = ((const f32x4*)bet)[lane + 64 * j]; }
    for (int m = gw; m < T; m += NGW) {
        const f32x4* xr = (const f32x4*)(in + (size_t)m * D) + lane;
        f32x4 v[4]; float s = 0.f;
#pragma unroll
        for (int j = 0; j < 4; ++j) { v[j] = xr[64 * j]; s += (v[j].x + v[j].y) + (v[j].z + v[j].w); }
#pragma unroll
        for (int o = 1; o < 64; o <<= 1) s += __shfl_xor(s, o);
        const float mean = s * (1.f / D); float s2 = 0.f;
#pragma unroll
        for (int j = 0; j < 4; ++j) { v[j] = v[j] - mean; s2 += (v[j].x * v[j].x + v[j].y * v[j].y) + (v[j].z * v[j].z + v[j].w * v[j].w); }
#pragma unroll
        for (int o = 1; o < 64; o <<= 1) s2 += __shfl_xor(s2, o);
        const float rstd = 1.f / sqrtf(s2 * (1.f / D) + LN_EPS);
        f32x4* of = (f32x4*)(outf + (size_t)m * D) + lane;
#pragma unroll
        for (int j = 0; j < 4; ++j) {
            const f32x4 y = v[j] * rstd * gv[j] + bv[j];
            of[64 * j] = y;
            if (WRITE_BF) { u32x2 o; o.x = pk2(y.x, y.y); o.y = pk2(y.z, y.w); ((u32x2*)(outb + (size_t)m * D))[lane + 64 * j] = o; }
        }
    }
}

#define GAS __attribute__((address_space(1)))
#define LDS_BARRIER() do { asm volatile("s_waitcnt lgkmcnt(0)" ::: "memory"); __builtin_amdgcn_s_barrier(); asm volatile("" ::: "memory"); } while (0)
#define MFMA32(a, b, c) __builtin_amdgcn_mfma_f32_32x32x16_bf16((a), (b), (c), 0, 0, 0)
constexpr int SLOT_BYTES = 16384, L_IMPW = 65536, L_IMPS = 99328, L_SEL = 107776, L_MISC = 108032;
#ifdef PROBE_A2
constexpr unsigned NITEMS_Q = 6144u;
#else
constexpr unsigned NITEMS_Q = 4096u;
#endif
#define WAIT_VM(n) asm volatile("s_waitcnt vmcnt(" #n ")" ::: "memory")
constexpr float NEG_INF = -__builtin_inff();
__device__ __forceinline__ int crow(int r, int h) { return (r & 3) + 8 * (r >> 2) + 4 * h; }
__device__ __forceinline__ void tile_dma(const bf16_t* kt, const bf16_t* vt, int vstride, LAS unsigned char* slot, int wave, int lane) {
    const int row = wave * 8 + (lane >> 3), c = (lane & 7) ^ ((row >> 1) & 7);
    __builtin_amdgcn_global_load_lds((const unsigned*)(kt + row * 64 + c * 8), (LAS unsigned*)(slot + wave * 1024), 16, 0, 0);
    __builtin_amdgcn_global_load_lds((const unsigned*)(vt + (size_t)row * vstride + c * 8), (LAS unsigned*)(slot + 8192 + wave * 1024), 16, 0, 0);
}
#define SCHED_FENCE() __builtin_amdgcn_sched_barrier(0)
__device__ __forceinline__ float xor32_max(float x) { const unsigned u = __builtin_bit_cast(unsigned, x); const auto r = __builtin_amdgcn_permlane32_swap(u, u, false, false); return fmaxf(__builtin_bit_cast(float, (unsigned)r[0]), __builtin_bit_cast(float, (unsigned)r[1])); }
__device__ __forceinline__ float xor32_sum(float x) { const unsigned u = __builtin_bit_cast(unsigned, x); const auto r = __builtin_amdgcn_permlane32_swap(u, u, false, false); return __builtin_bit_cast(float, (unsigned)r[0]) + __builtin_bit_cast(float, (unsigned)r[1]); }
__device__ __forceinline__ void tile_kread(bf16x8 (&kf)[8], const LAS unsigned char* kb, int q, int g) {
    const LAS unsigned char* a = kb + q * 128; const int f = (q >> 1) & 7;
#pragma unroll
    for (int ks = 0; ks < 4; ++ks) { const int off = ((2 * ks + g) ^ f) * 16; kf[2 * ks] = *(const LAS bf16x8*)(a + off); kf[2 * ks + 1] = *(const LAS bf16x8*)(a + 32 * 128 + off); }
}
__device__ __forceinline__ void tile_qk_mfma(f32x16& p0, f32x16& p1, const bf16x8 (&kf)[8], const bf16x8 (&qf)[4]) {
#pragma unroll
    for (int i = 0; i < 16; ++i) { p0[i] = 0.f; p1[i] = 0.f; }
#pragma unroll
    for (int ks = 0; ks < 4; ++ks) { p0 = MFMA32(kf[2 * ks], qf[ks], p0); p1 = MFMA32(kf[2 * ks + 1], qf[ks], p1); }
}
__device__ __forceinline__ void tile_vread(bf16x8 (&vf)[8], const LAS unsigned char* vb, int q, int g) {
#pragma unroll
    for (int h2 = 0; h2 < 2; ++h2)
#pragma unroll
        for (int s = 0; s < 2; ++s)
#pragma unroll
            for (int dt = 0; dt < 2; ++dt) {
                const LAS unsigned char* vr = vb + (32 * dt + q) * 128 + 8 * g; const int f = (q >> 1) & 7, c = 4 * h2 + 2 * s;
                const u32x2 lo = *(const LAS u32x2*)(vr + ((c ^ f) * 16)), hi = *(const LAS u32x2*)(vr + (((c + 1) ^ f) * 16));
                const u32x4 vw = {lo.x, lo.y, hi.x, hi.y};
                vf[h2 * 4 + s * 2 + dt] = __builtin_bit_cast(bf16x8, vw);
            }
}
__device__ __forceinline__ void tile_pv_mfma(f32x16 (&o)[2], const f32x16& p, int h2, const bf16x8 (&vf)[8]) {
#pragma unroll
    for (int s = 0; s < 2; ++s) {
        u32x4 pw; pw.x = pk2(p[8 * s], p[8 * s + 1]); pw.y = pk2(p[8 * s + 2], p[8 * s + 3]); pw.z = pk2(p[8 * s + 4], p[8 * s + 5]); pw.w = pk2(p[8 * s + 6], p[8 * s + 7]);
        const bf16x8 pf = __builtin_bit_cast(bf16x8, pw);
#pragma unroll
        for (int dt = 0; dt < 2; ++dt) o[dt] = MFMA32(h2 ? vf[4 + s * 2 + dt] : vf[s * 2 + dt], pf, o[dt]);
    }
}
__device__ __forceinline__ void softmax_update(f32x16& p0, f32x16& p1, float& m, float& l, f32x16 (&o)[2]) {
    float mx = fmaxf(p0[0], p1[0]);
#pragma unroll
    for (int i = 1; i < 16; ++i) mx = fmaxf(mx, fmaxf(p0[i], p1[i]));
    mx = xor32_max(mx);
    const float mn = fmaxf(m, mx), mu = (mn == NEG_INF) ? 0.f : mn;
    const float alpha = __builtin_amdgcn_exp2f(m - mu);
    m = mn;
    float rs = 0.f;
#pragma unroll
    for (int i = 0; i < 16; ++i) { p0[i] = __builtin_amdgcn_exp2f(p0[i] - mu); p1[i] = __builtin_amdgcn_exp2f(p1[i] - mu); rs += p0[i] + p1[i]; }
    l = l * alpha + rs;
    o[0] = o[0] * alpha; o[1] = o[1] * alpha;
}
__device__ __forceinline__ void zero_o(f32x16 (&o)[2]) {
#pragma unroll
    for (int i = 0; i < 16; ++i) { o[0][i] = 0.f; o[1][i] = 0.f; }
}
template <bool SEL> __device__ __forceinline__ void tile_compute(f32x16 (&o)[2], float& m, float& l, const bf16x8 (&qf)[4], const LAS unsigned char* kb, const LAS unsigned char* vb,
                                                                 int j, int jlow, int jdiag, unsigned selbits, int q, int g, int tok) {
    f32x16 p0, p1;
    { bf16x8 kf[8]; tile_kread(kf, kb, q, g); SCHED_FENCE(); tile_qk_mfma(p0, p1, kf, qf); SCHED_FENCE(); }
    bf16x8 vf[8]; tile_vread(vf, vb, q, g); SCHED_FENCE();
    if (SEL) { if (!((selbits >> j) & 1u)) {
#pragma unroll
        for (int i = 0; i < 16; ++i) { p0[i] = NEG_INF; p1[i] = NEG_INF; } } }
    if (j == jdiag) {
#pragma unroll
        for (int i = 0; i < 16; ++i) { const int kv = crow(i, g); if (kv > tok) p0[i] = NEG_INF; if (kv + 32 > tok) p1[i] = NEG_INF; }
    }
    if (j == jlow) {
#pragma unroll
        for (int i = 0; i < 16; ++i) { const int kv = crow(i, g); if (kv <= tok) p0[i] = NEG_INF; if (kv + 32 <= tok) p1[i] = NEG_INF; }
    }
    softmax_update(p0, p1, m, l, o);
    tile_pv_mfma(o, p0, 0, vf); tile_pv_mfma(o, p1, 1, vf);
}
template <bool SEL> __device__ __forceinline__ void stream_pass(f32x16 (&o)[2], float& m, float& l, const bf16x8 (&qf)[4], const bf16_t* kbase, const bf16_t* vtbase,
                                                                unsigned tilemask, int jlow, int jdiag, unsigned selbits, LAS unsigned char* lds, int wave, int lane, int q, int g, int tok) {
    unsigned rem = tilemask;
    const int n = __builtin_popcount(tilemask);
    WAIT_VM(0);
    int jq0 = __builtin_ctz(rem), jq1 = 0, jq2 = 0; rem &= rem - 1;
    tile_dma(kbase + (size_t)jq0 * 4096, vtbase + jq0 * 64, 2048, lds, wave, lane);
    if (n > 1) { jq1 = __builtin_ctz(rem); rem &= rem - 1; tile_dma(kbase + (size_t)jq1 * 4096, vtbase + jq1 * 64, 2048, lds + SLOT_BYTES, wave, lane); }
    if (n > 2) { jq2 = __builtin_ctz(rem); rem &= rem - 1; tile_dma(kbase + (size_t)jq2 * 4096, vtbase + jq2 * 64, 2048, lds + 2 * SLOT_BYTES, wave, lane); }
    for (int i = 0; i < n; ++i) {
        const int ahead = n - 1 - i;
        if (ahead >= 2) WAIT_VM(4); else if (ahead == 1) WAIT_VM(2); else WAIT_VM(0);
        LDS_BARRIER();
        int jq3 = 0;
        if (i + 3 < n) { jq3 = __builtin_ctz(rem); rem &= rem - 1; tile_dma(kbase + (size_t)jq3 * 4096, vtbase + jq3 * 64, 2048, lds + ((i + 3) & 3) * SLOT_BYTES, wave, lane); }
        const LAS unsigned char* sl = lds + (i & 3) * SLOT_BYTES;
        tile_compute<SEL>(o, m, l, qf, sl, sl + 8192, jq0, jlow, jdiag, selbits, q, g, tok);
        jq0 = jq1; jq1 = jq2; jq2 = jq3;
    }
    LDS_BARRIER();
}
__device__ __forceinline__ void imp_sub(const f32x16& p, int st, float& carry, LAS float* row, int g) {
#pragma unroll
    for (int a = 0; a < 4; ++a) {
        const float bsum = (p[4 * a] + p[4 * a + 1]) + (p[4 * a + 2] + p[4 * a + 3]), last = p[4 * a + 3];
        const float recv = __shfl_xor(last, 32);
        row[8 * st + 2 * a + g] = bsum + (g ? recv : carry);
        carry = recv;
    }
}
__device__ __forceinline__ void load_q(bf16x8 (&qf)[4], const bf16_t* qrow, int g) {
#pragma unroll
    for (int ks = 0; ks < 4; ++ks) qf[ks] = *(const GAS bf16x8*)(qrow + 16 * ks + 8 * g);
    asm volatile("" : "+v"(qf[0]), "+v"(qf[1]), "+v"(qf[2]), "+v"(qf[3]));
}
__device__ __forceinline__ void store_o(const f32x16 (&o)[2], bf16_t* orow, int g) {
#pragma unroll
    for (int dt = 0; dt < 2; ++dt)
#pragma unroll
        for (int a = 0; a < 4; ++a) { u32x2 w; w.x = pk2(o[dt][4 * a], o[dt][4 * a + 1]); w.y = pk2(o[dt][4 * a + 2], o[dt][4 * a + 3]); *(GAS u32x2*)(orow + 32 * dt + 8 * a + 4 * g) = w; }
}

__device__ __forceinline__ unsigned next_item(unsigned* ctr, unsigned& curq, unsigned& tried) {
    while (tried < 8u) {
        const unsigned i = __hip_atomic_fetch_add((GAS unsigned*)(ctr + 16 * curq), 1u, __ATOMIC_RELAXED, __HIP_MEMORY_SCOPE_AGENT);
        if (i < 512u) return curq * 512u + i;
        curq = (curq + 1u) & 7u; ++tried;
    }
    return 0xffffffffu;
}
__device__ __forceinline__ void attn_phase(const Params& P, LAS unsigned char* lds, int cidx = 0) {
    unsigned* counter = (unsigned*)(P.ws + WS_CTL) + 128 * cidx;
    unsigned curq = (unsigned)__builtin_amdgcn_s_getreg((3 << 11) | 20) & 7u, tried = 0u;
    bool first = true;
    for (;;) {
        int tid = threadIdx.x; asm volatile("" : "+v"(tid));
        const int lane = tid & 63, wave = __builtin_amdgcn_readfirstlane(tid >> 6);
        const int q = lane & 31, g = lane >> 5, hh = wave >> 1, tok = (wave & 1) * 32 + q;
        if (first) { if (tid == 0) *(LAS unsigned*)(lds + L_MISC) = next_item(counter, curq, tried); first = false; }
        LDS_BARRIER();
        const unsigned idx = *(volatile LAS unsigned*)(lds + L_MISC);
        LDS_BARRIER();
        if (idx == 0xffffffffu) break;
        unsigned nextidx = 0u; if (tid == 0) nextidx = next_item(counter, curq, tried);
        unsigned char* ws = P.ws; asm volatile("" : "+s"(ws));
        const int xq = (int)(idx >> 9), li = (int)(idx & 511u); const bool isB = li < 256;
        const int qb = 31 - (li & 31), bg = xq * 8 + ((li >> 5) & 7);
        const int b = bg >> 1, gkv = bg & 1, head = gkv * 4 + hh;
        const size_t trow = (size_t)b * 2048 + qb * 64 + tok;
        bf16x8 qf[4]; f32x16 o[2];
        if (!isB) {
            load_q(qf, (const bf16_t*)(ws + WS_QA) + trow * 512 + head * 64, g);
            float m = ((const GAS float*)P.sinks)[head] * LOG2E, l = 0.5f; zero_o(o);
            asm volatile("" : "+v"(m));
            const int lo = qb >= 2 ? qb - 2 : 0;
            const unsigned tm = ((2u << qb) - 1u) & ~((1u << lo) - 1u);
            stream_pass<false>(o, m, l, qf, (const bf16_t*)(ws + WS_KA) + (size_t)bg * 2048 * 64, (const bf16_t*)(ws + WS_VAT) + (size_t)bg * 64 * 2048, tm, qb - 2, qb, 0u, lds, wave, lane, q, g, tok);
            const float lt = xor32_sum(l), inv = 1.f / lt;
            o[0] = o[0] * inv; o[1] = o[1] * inv;
            store_o(o, (bf16_t*)(ws + WS_OA) + trow * 512 + head * 64, g);
        } else {
            f32x16 acc[2];
            const GAS bf16_t* gnp = (const GAS bf16_t*)(ws + WS_GN) + trow * 32 + head;
            float g0 = bflo((unsigned)gnp[0]), g1 = bflo((unsigned)gnp[8]), g2 = bflo((unsigned)gnp[16]);
            asm volatile("" : "+v"(g0), "+v"(g1), "+v"(g2));
            {
                load_q(qf, (const bf16_t*)(ws + WS_QN) + trow * 512 + head * 64, g);
                const bf16_t* kc = (const bf16_t*)(ws + WS_KCMP) + (size_t)bg * 128 * 64; const bf16_t* vct = (const bf16_t*)(ws + WS_VCMPT) + (size_t)bg * 64 * 128;
                const bool two = qb >= 16;
                tile_dma(kc, vct, 128, lds, wave, lane); if (two) tile_dma(kc + 64 * 64, vct + 64, 128, lds + SLOT_BYTES, wave, lane);
                WAIT_VM(0); LDS_BARRIER();
                f32x16 p0, p1, p2, p3;
                { bf16x8 kf[8]; tile_kread(kf, lds, q, g); SCHED_FENCE(); tile_qk_mfma(p0, p1, kf, qf); SCHED_FENCE(); }
                if (two) { bf16x8 kf[8]; tile_kread(kf, lds + SLOT_BYTES, q, g); SCHED_FENCE(); tile_qk_mfma(p2, p3, kf, qf); SCHED_FENCE(); }
                else {
#pragma unroll
                    for (int i = 0; i < 16; ++i) { p2[i] = NEG_INF; p3[i] = NEG_INF; } }
                const int cmax = (qb * 64 + tok - 31) >> 4;
                float mx = NEG_INF;
#pragma unroll
                for (int i = 0; i < 16; ++i) { const int c = crow(i, g);
                    if (c > cmax) p0[i] = NEG_INF; if (c + 32 > cmax) p1[i] = NEG_INF; if (c + 64 > cmax) p2[i] = NEG_INF; if (c + 96 > cmax) p3[i] = NEG_INF;
                    mx = fmaxf(fmaxf(mx, fmaxf(p0[i], p1[i])), fmaxf(p2[i], p3[i])); }
                mx = xor32_max(mx);
                const float mu = (mx == NEG_INF) ? 0.f : mx;
                float rs = 0.f;
#pragma unroll
                for (int i = 0; i < 16; ++i) { p0[i] = __builtin_amdgcn_exp2f(p0[i] - mu); p1[i] = __builtin_amdgcn_exp2f(p1[i] - mu); p2[i] = __builtin_amdgcn_exp2f(p2[i] - mu); p3[i] = __builtin_amdgcn_exp2f(p3[i] - mu);
                    rs += (p0[i] + p1[i]) + (p2[i] + p3[i]); }
                rs = xor32_sum(rs);
                const float inv = rs > 0.f ? 1.f / rs : 0.f;
                p0 = p0 * inv; p1 = p1 * inv; p2 = p2 * inv; p3 = p3 * inv;
                LAS float* irow = (LAS float*)(lds + L_IMPW) + (hh * 64 + tok) * 33;
                float carry = 0.f;
                imp_sub(p0, 0, carry, irow, g); imp_sub(p1, 1, carry, irow, g); imp_sub(p2, 2, carry, irow, g); imp_sub(p3, 3, carry, irow, g);
                zero_o(o);
                { bf16x8 vf[8]; tile_vread(vf, lds + 8192, q, g); SCHED_FENCE(); tile_pv_mfma(o, p0, 0, vf); tile_pv_mfma(o, p1, 1, vf); }
                if (two) { bf16x8 vf[8]; tile_vread(vf, lds + SLOT_BYTES + 8192, q, g); SCHED_FENCE(); tile_pv_mfma(o, p2, 0, vf); tile_pv_mfma(o, p3, 1, vf); }
                acc[0] = o[0] * g0; acc[1] = o[1] * g0;
                LDS_BARRIER();
            }
            unsigned selbits, uni;
            {
                const int tk = tid >> 3, jj = tid & 7;
                const LAS float* iw = (const LAS float*)(lds + L_IMPW); LAS float* is = (LAS float*)(lds + L_IMPS);
#pragma unroll
                for (int k = 0; k < 4; ++k) { const int j = jj + 8 * k;
                    is[tk * 33 + j] = ((iw[(0 * 64 + tk) * 33 + j] + iw[(1 * 64 + tk) * 33 + j]) + iw[(2 * 64 + tk) * 33 + j]) + iw[(3 * 64 + tk) * 33 + j]; }
                LDS_BARRIER();
                unsigned part = 0u;
                if (qb <= 15) {
#pragma unroll
                    for (int k = 0; k < 4; ++k) { const int j = jj + 8 * k; if (j <= qb) part |= 1u << j; }
                } else {
#pragma unroll
                    for (int k = 0; k < 4; ++k) { const int j = jj + 8 * k; bool sel;
                        if (j == 0 || j == qb || j == qb - 1) sel = true;
                        else if (j > qb) sel = false;
                        else { const float v = is[tk * 33 + j]; int rank = 0;
                            for (int j2 = 1; j2 <= qb - 2; ++j2) { const float v2 = is[tk * 33 + j2]; rank += (v2 > v || (v2 == v && j2 < j)) ? 1 : 0; }
                            sel = rank < 13; }
                        if (sel) part |= 1u << j; }
                }
                part |= __shfl_xor(part, 1); part |= __shfl_xor(part, 2); part |= __shfl_xor(part, 4);
                if (jj == 0) *(LAS unsigned*)(lds + L_SEL + 4 * tk) = part;
                LDS_BARRIER();
                selbits = *(const LAS unsigned*)(lds + L_SEL + 4 * tok);
                uni = *(const LAS unsigned*)(lds + L_SEL + 4 * lane);
#pragma unroll
                for (int s = 1; s < 64; s <<= 1) uni |= __shfl_xor(uni, s);
                uni = __builtin_amdgcn_readfirstlane(uni);
            }
            load_q(qf, (const bf16_t*)(ws + WS_QNR) + trow * 512 + head * 64, g);
            {
                float m = NEG_INF, l = 0.f; zero_o(o);
                const unsigned tm = uni & ((2u << qb) - 1u);
                stream_pass<true>(o, m, l, qf, (const bf16_t*)(ws + WS_KSL) + (size_t)bg * 2048 * 64, (const bf16_t*)(ws + WS_VSLT) + (size_t)bg * 64 * 2048, tm, -1, qb, selbits, lds, wave, lane, q, g, tok);
                const float lt = xor32_sum(l), sc = g1 / lt;
                acc[0] = acc[0] + o[0] * sc; acc[1] = acc[1] + o[1] * sc;
            }
            {
                float m = NEG_INF, l = 0.f; zero_o(o);
                const int lo = qb >= 8 ? qb - 8 : 0;
                const unsigned tm = ((2u << qb) - 1u) & ~((1u << lo) - 1u);
                stream_pass<false>(o, m, l, qf, (const bf16_t*)(ws + WS_KW) + (size_t)bg * 2048 * 64, (const bf16_t*)(ws + WS_VWT) + (size_t)bg * 64 * 2048, tm, qb - 8, qb, 0u, lds, wave, lane, q, g, tok);
                const float lt = xor32_sum(l), sc = g2 / lt;
                acc[0] = acc[0] + o[0] * sc; acc[1] = acc[1] + o[1] * sc;
            }
            store_o(acc, (bf16_t*)(ws + WS_OB) + trow * 512 + head * 64, g);
        }
        if (tid == 0) *(LAS unsigned*)(lds + L_MISC) = nextidx;
    }
}

#ifndef MK_PHASE_HI
#define MK_PHASE_HI 99
#endif
__global__ void __launch_bounds__(NTHREADS, 2) fwd_megakernel(Params P) {
    extern __shared__ __attribute__((aligned(16))) unsigned char lds_raw[];
    LAS unsigned char* lds = (LAS unsigned char*)lds_raw;
    cg::grid_group grid = cg::this_grid();
#define MK_TID() int tid = threadIdx.x; asm volatile("" : "+v"(tid)); const int lane = tid & 63, wave = __builtin_amdgcn_readfirstlane(tid >> 6); (void)lane; (void)wave
    unsigned char* ws = P.ws;
    const int G = gridDim.x, bid = blockIdx.x;

    { MK_TID(); p0_prologue(P, lds, tid, lane, wave); }
    grid.sync();

#ifndef NO_P1
    {
        if (bid == 0) {
            MK_TID();
            const int which = tid >> 8, n = tid & 255;
            const float* part = (const float*)(ws + WS_CPART) + (size_t)which * 64 * 256 + n;
            float s = (which ? P.b1_v : P.b1_k)[n];
#pragma unroll 8
            for (int kc = 0; kc < 64; ++kc) s += part[kc * 256];
            ((float*)(ws + WS_CBIAS))[which * 256 + n] = s;
        }
        pg8::Gemm g{(const bf16_t*)(ws + WS_XB), (const bf16_t*)(ws + WS_WIN), T, DINP, 1024, 1024};
        pg8::StaticOrder S; S.init(T, DINP, G, bid);
        EpiZ E{ws};
        pg8::gemm_phase<EpiZ, pg8::StaticOrder, true, true>(lds, g, S, E);
    }
#endif
    grid.sync();

    if (bid < 64) {
        const int which = bid & 1, c = bid >> 1;
        pg8::Gemm g{(const bf16_t*)(ws + (which ? WS_VC : WS_KC)), (const bf16_t*)(ws + (which ? WS_CW1V : WS_CW1K)), 8192, 256, 2048, 1024};
        pg8::StaticOrder S; S.init(8192, 256, 32, c);
        EpiC1 E{(bf16_t*)(ws + (which ? WS_H1V : WS_H1K)), (const float*)(ws + WS_CBIAS) + which * 256};
        pg8::gemm_phase<EpiC1, pg8::StaticOrder, true, true>(lds, g, S, E);
    }
    grid.sync();

    if (bid < 64) {
        const int which = bid & 1, c = bid >> 1;
        pg8::Gemm g{(const bf16_t*)(ws + (which ? WS_H1V : WS_H1K)), (const bf16_t*)(ws + (which ? WS_CW2V : WS_CW2K)), 8192, 256, 256, 256};
        pg8::StaticOrder S; S.init(8192, 256, 32, c);
        EpiC2 E{(bf16_t*)(ws + (which ? WS_VCMPT : WS_KCMP)), which};
        pg8::gemm_phase<EpiC2, pg8::StaticOrder, true, true>(lds, g, S, E);
    }
    grid.sync();

#ifndef NO_ATTN
    attn_phase(P, lds);
#ifdef PROBE_ATTN2
    grid.sync();
    attn_phase(P, lds, 1);
#endif
#endif
    grid.sync();

    {
        pg8::StaticOrder S; S.init(T, 1024, G, bid);
        { pg8::Gemm g{(const bf16_t*)(ws + WS_OA), (const bf16_t*)(ws + WS_WPA), T, 1024, 512, 512};
          EpiProj<false> E{(const bf16_t*)(ws + WS_GM), nullptr, (bf16_t*)(ws + WS_T1)};
          pg8::gemm_phase<EpiProj<false>, pg8::StaticOrder, true, true>(lds, g, S, E); }
        { pg8::Gemm g{(const bf16_t*)(ws + WS_OB), (const bf16_t*)(ws + WS_WPB), T, 1024, 512, 512};
          EpiProj<true> E{(const bf16_t*)(ws + WS_GM), (const bf16_t*)(ws + WS_T1), (bf16_t*)(ws + WS_Y)};
          pg8::gemm_phase<EpiProj<true>, pg8::StaticOrder, true, true>(lds, g, S, E); }
    }
    grid.sync();

    {
        pg8::Gemm g{(const bf16_t*)(ws + WS_Y), (const bf16_t*)(ws + WS_WOUT), T, 1024, 1024, 1024};
        pg8::StaticOrder S; S.init(T, 1024, G, bid);
        EpiRes E{P.x, (float*)(ws + WS_PRE1)};
        pg8::gemm_phase<EpiRes, pg8::StaticOrder, true, true>(lds, g, S, E);
    }
    grid.sync();

    { MK_TID(); ln_phase<true>((const float*)(ws + WS_PRE1), (float*)(ws + WS_HF), (bf16_t*)(ws + WS_HB), P.ln1g, P.ln1b, lane, wave); }
    grid.sync();

    {
        pg8::Gemm g{(const bf16_t*)(ws + WS_HB), (const bf16_t*)(ws + WS_WGU), T, NGU, 1024, 1024};
        pg8::StaticOrder S; S.init(T, NGU, G, bid);
        EpiGU E{(bf16_t*)(ws + WS_ACT)};
        pg8::gemm_phase<EpiGU, pg8::StaticOrder, true, true>(lds, g, S, E);
    }
    grid.sync();

    {
        pg8::Gemm g{(const bf16_t*)(ws + WS_ACT), (const bf16_t*)(ws + WS_WDN), T, 1024, FF, FF};
        pg8::StaticOrder S; S.init(T, 1024, G, bid);
        EpiRes E{(const float*)(ws + WS_HF), P.out};
        pg8::gemm_phase<EpiRes, pg8::StaticOrder, true, true>(lds, g, S, E);
    }
    grid.sync();

    { MK_TID(); ln_phase<false>(P.out, P.out, nullptr, P.ln2g, P.ln2b, lane, wave); }
}
}

extern "C" void kernel_launch(void* const* d_in, const int* in_sizes, int n_in, void* d_out, int out_size, void* d_ws, size_t ws_size, hipStream_t stream) {
    static int grid = 0;
    if (grid == 0) {
        if (n_in != 21 || in_sizes[0] != mk::T * mk::D || out_size != mk::T * mk::D || ws_size < mk::WS_END) {
            fprintf(stderr, "kernel_launch: unexpected shapes (n_in %d, in0 %d, out %d, ws %zu); nothing launched\n", n_in, n_in > 0 ? in_sizes[0] : -1, out_size, ws_size); grid = -1; return; }
        int dev = 0, cus = 0, per_cu = 0;
        (void)hipGetDevice(&dev);
        (void)hipDeviceGetAttribute(&cus, hipDeviceAttributeMultiprocessorCount, dev);
        if (hipFuncSetAttribute((const void*)mk::fwd_megakernel, hipFuncAttributeMaxDynamicSharedMemorySize, mk::LDS_BYTES) != hipSuccess) { fprintf(stderr, "kernel_launch: hipFuncSetAttribute failed\n"); grid = -1; return; }
        if (hipOccupancyMaxActiveBlocksPerMultiprocessor(&per_cu, (const void*)mk::fwd_megakernel, mk::NTHREADS, mk::LDS_BYTES) != hipSuccess || per_cu < 1) { fprintf(stderr, "kernel_launch: occupancy query failed (%d)\n", per_cu); grid = -1; return; }
        grid = cus * (per_cu > 1 ? 1 : per_cu);
    }
    if (grid < 0) return;
    mk::Params p{};
    const float** pp = (const float**)&p;
    for (int i = 0; i < 21; ++i) pp[i] = (const float*)d_in[i];
    p.out = (float*)d_out; p.ws = (unsigned char*)d_ws;
    void* args[] = {&p};
    const hipError_t e = hipLaunchCooperativeKernel((const void*)mk::fwd_megakernel, dim3(grid), dim3(mk::NTHREADS), args, mk::LDS_BYTES, stream);
    if (e != hipSuccess) fprintf(stderr, "kernel_launch: cooperative launch failed: %s (grid %d)\n", hipGetErrorString(e), grid);
}
```

```cpp
#include <hip/hip_runtime.h>
#include <hip/hip_cooperative_groups.h>
#include <cstdio>
#include <cstdint>
namespace cg = cooperative_groups;
namespace pg8 {
#define PG8_LAS __attribute__((address_space(3)))
typedef unsigned short bf16_t;
typedef short bf16x8 __attribute__((ext_vector_type(8)));
typedef float f32x4 __attribute__((ext_vector_type(4)));
typedef unsigned u32x4 __attribute__((ext_vector_type(4)));
constexpr int BM = 256, BK = 64, HALF = 128, HTB = HALF * BK * 2  , STAGE_BYTES = 8 * HTB, NXCD = 8, WGM = 8;

__host__ __device__ __forceinline__ int lds_byte(int r, int c) { const int st = (r >> 4) * 2 + (c >> 5), rr = r & 15, cc = c & 31, ob = rr * 64 + cc * 2; return st * 1024 + (ob ^ (((ob >> 9) & 1) << 5)); }
__host__ __device__ __forceinline__ void stage_rc(int b, int& R, int& C) { const int st = b / 1024, sb = b % 1024, swz = sb ^ (((sb >> 9) & 1) << 5); R = (st >> 1) * 16 + swz / 64; C = (st & 1) * 32 + (swz % 64) / 2; }
__host__ __device__ __forceinline__ int perm32(int rho) { const int n = rho >> 4, i = rho & 15; return 8 * (i >> 2) + 4 * n + (i & 3); }

struct Unit { int pm, pn; };
struct Gemm { const bf16_t* A; const bf16_t* Bt; int M, N, K, lda; };

struct StaticOrder {
    int nM, nN, nwg, G, c;
    __host__ __device__ void init(int M, int N, int G_, int c_) { nM = M / BM; nN = N / BM; nwg = nM * nN; G = G_; c = c_; }
    __host__ __device__ bool next(int i, Unit& u) const {
        const long L = (long)i * G + c; if (L >= nwg) return false;
        int wgid = (int)L; { const int q = nwg / NXCD, r = nwg % NXCD, xcd = wgid % NXCD, off = wgid / NXCD; wgid = (xcd < r ? xcd * (q + 1) : r * (q + 1) + (xcd - r) * q) + off; }
        const int nig = WGM * nN, gid = wgid / nig, fm = gid * WGM, gsz = (nM - fm) < WGM ? (nM - fm) : WGM;
        u.pm = fm + ((wgid % nig) % gsz); u.pn = (wgid % nig) / gsz; return true;
    }
    __device__ __forceinline__ void a_ready(const Unit&) const {}
    __device__ __forceinline__ void done(const Unit&) const {}
};

__device__ __forceinline__ unsigned cvt_pk_bf16(float lo, float hi) { unsigned r; asm volatile("v_cvt_pk_bf16_f32 %0, %1, %2" : "=v"(r) : "v"(lo), "v"(hi)); return r; }
template <class Epi, class Sched, bool ALIGN_EPI = false, bool SP2 = false>
__device__ __forceinline__ void gemm_phase(PG8_LAS unsigned char* lds, const Gemm g, const Sched& S, const Epi& E) {
    int tid = threadIdx.x; asm volatile("" : "+v"(tid));
    const int wid = __builtin_amdgcn_readfirstlane(tid >> 6), lane = tid & 63, wr = wid >> 2, wc = wid & 3, fr = lane & 15, fq = lane >> 4;
    const int K = g.K, lda = g.lda, nt = K / BK;
    unsigned voffA[2], voffB[2];
#pragma unroll
    for (int i = 0; i < 2; ++i) { int R, C; stage_rc(tid * 16 + i * 8192, R, C); const int Rb = Epi::PERM ? ((R & ~31) + perm32(R & 31)) : R;
        voffA[i] = (unsigned)(R * lda + C) * 2u; voffB[i] = (unsigned)(Rb * K + C) * 2u; }
    const size_t kstep = (size_t)(BK * 2);
    const size_t hstepB = (size_t)HALF * K * 2, hstepA = (size_t)HALF * lda * 2;
    const size_t tstepB = 2 * hstepB, tstepA = 2 * hstepA;
    const unsigned ldsw = (unsigned)wid * 1024u;
    const int aoff = lds_byte(wr * 64 + fr, fq * 8), boff = lds_byte(wc * 32 + fr, fq * 8);
#define PG8_SA(b, h) (((b) * 2 + (h)) * HTB)
#define PG8_SB(b, h) ((4 + (b) * 2 + (h)) * HTB)
#define PG8_STAGE(bufoff, gbase, voff) do { _Pragma("unroll") for (int _i = 0; _i < 2; ++_i) \
        __builtin_amdgcn_global_load_lds((const unsigned*)((const char*)(gbase) + (voff)[_i]), (PG8_LAS unsigned*)(lds + (bufoff) + ldsw + _i * 8192), 16, 0, 0); } while (0)
#define PG8_LDA(dst, b, h) do { _Pragma("unroll") for (int m = 0; m < 4; ++m) _Pragma("unroll") for (int k = 0; k < 2; ++k) dst[m][k] = *(const PG8_LAS bf16x8*)(lds + PG8_SA(b, h) + aoff + m * 2048 + k * 1024); } while (0)
#define PG8_LDB(dst, b, h) do { _Pragma("unroll") for (int n = 0; n < 2; ++n) _Pragma("unroll") for (int k = 0; k < 2; ++k) dst[n][k] = *(const PG8_LAS bf16x8*)(lds + PG8_SB(b, h) + boff + n * 2048 + k * 1024); } while (0)
#define PG8_MMA(ai, bj, At, Bt) do { __builtin_amdgcn_s_setprio(1); _Pragma("unroll") for (int m = 0; m < 4; ++m) _Pragma("unroll") for (int n = 0; n < 2; ++n) _Pragma("unroll") for (int k = 0; k < 2; ++k) \
        acc[ai][bj][m][n] = __builtin_amdgcn_mfma_f32_16x16x32_bf16(Bt[n][k], At[m][k], acc[ai][bj][m][n], 0, 0, 0); __builtin_amdgcn_s_setprio(0); } while (0)
#define PG8_WAIT_V(n) asm volatile("s_waitcnt vmcnt(" #n ")" ::: "memory")
#define PG8_WAIT_L(n) asm volatile("s_waitcnt lgkmcnt(" #n ")" ::: "memory")
#define PG8_BAR __builtin_amdgcn_s_barrier()
#define PG8_SCHED __builtin_amdgcn_sched_barrier(0)
    Unit cur, nxt; int ui = 0;
    if (!S.next(0, cur)) return;
    f32x4 acc[2][2][4][2];
#pragma unroll
    for (int a = 0; a < 2; ++a)
#pragma unroll
        for (int b = 0; b < 2; ++b)
#pragma unroll
            for (int m = 0; m < 4; ++m)
#pragma unroll
                for (int n = 0; n < 2; ++n) acc[a][b][m][n] = (f32x4){0.f, 0.f, 0.f, 0.f};
    bf16x8 At[4][2], B0[2][2], B1[2][2];
    const char* cA = (const char*)g.A + (size_t)cur.pm * tstepA; const char* cB = (const char*)g.Bt + (size_t)cur.pn * tstepB;
    S.a_ready(cur);
    if constexpr (SP2) {
        PG8_STAGE(PG8_SB(0, 0), cB, voffB); PG8_STAGE(PG8_SB(0, 1), cB + hstepB, voffB); PG8_STAGE(PG8_SA(0, 0), cA, voffA); PG8_STAGE(PG8_SA(0, 1), cA + hstepA, voffA);
        if (wr == 1) PG8_BAR;
        PG8_WAIT_V(2); PG8_BAR;
        PG8_STAGE(PG8_SB(1, 0), cB + kstep, voffB); PG8_STAGE(PG8_SA(1, 0), cA + kstep, voffA); PG8_STAGE(PG8_SB(1, 1), cB + hstepB + kstep, voffB);
        PG8_WAIT_V(6); PG8_BAR;
    } else {
        PG8_STAGE(PG8_SB(0, 0), cB, voffB); PG8_STAGE(PG8_SA(0, 0), cA, voffA); PG8_STAGE(PG8_SB(0, 1), cB + hstepB, voffB); PG8_STAGE(PG8_SA(0, 1), cA + hstepA, voffA);
        if (wr == 1) PG8_BAR;
        PG8_WAIT_V(4); PG8_BAR;
        PG8_STAGE(PG8_SB(1, 0), cB + kstep, voffB); PG8_STAGE(PG8_SA(1, 0), cA + kstep, voffA); PG8_STAGE(PG8_SB(1, 1), cB + hstepB + kstep, voffB);
        PG8_WAIT_V(6); PG8_BAR;
    }
    for (;;) {
        const bool has_next = S.next(ui + 1, nxt);
        const char* nA = has_next ? (const char*)g.A + (size_t)nxt.pm * tstepA : cA; const char* nB = has_next ? (const char*)g.Bt + (size_t)nxt.pn * tstepB : cB;
        for (int t = 0; t < nt; t += 2) {
            const bool last = (t == nt - 2);
            const char* a1 = cA + (size_t)(t + 1) * kstep;
            const char* a2 = last ? nA : cA + (size_t)(t + 2) * kstep; const char* b2 = last ? nB : cB + (size_t)(t + 2) * kstep;
            const char* a3 = a2 + kstep; const char* b3 = b2 + kstep;
            if (last && has_next) S.a_ready(nxt);
            if constexpr (SP2) {
            PG8_LDB(B0, 0, 0); PG8_LDB(B1, 0, 1); PG8_SCHED; PG8_LDA(At, 0, 0); PG8_STAGE(PG8_SA(1, 1), a1 + hstepA, voffA);
            PG8_WAIT_V(8); PG8_WAIT_L(0); PG8_BAR; PG8_MMA(0, 0, At, B0); PG8_MMA(0, 1, At, B1); PG8_BAR; PG8_SCHED;
            PG8_LDA(At, 0, 1); PG8_STAGE(PG8_SB(0, 0), b2, voffB); PG8_STAGE(PG8_SB(0, 1), b2 + hstepB, voffB); PG8_STAGE(PG8_SA(0, 0), a2, voffA);
            PG8_WAIT_V(8); PG8_WAIT_L(0); PG8_BAR; PG8_MMA(1, 0, At, B0); PG8_MMA(1, 1, At, B1); PG8_BAR; PG8_SCHED;
            PG8_LDB(B0, 1, 0); PG8_LDB(B1, 1, 1); PG8_SCHED; PG8_LDA(At, 1, 0); PG8_STAGE(PG8_SA(0, 1), a2 + hstepA, voffA);
            PG8_WAIT_V(8); PG8_WAIT_L(0); PG8_BAR; PG8_MMA(0, 0, At, B0); PG8_MMA(0, 1, At, B1); PG8_BAR; PG8_SCHED;
            PG8_LDA(At, 1, 1); PG8_STAGE(PG8_SB(1, 0), b3, voffB); PG8_STAGE(PG8_SB(1, 1), b3 + hstepB, voffB); PG8_STAGE(PG8_SA(1, 0), a3, voffA);
            PG8_WAIT_V(8); PG8_WAIT_L(0); PG8_BAR; PG8_MMA(1, 0, At, B0); PG8_MMA(1, 1, At, B1); PG8_BAR; PG8_SCHED;
            } else {
            PG8_LDB(B0, 0, 0); PG8_SCHED; PG8_LDA(At, 0, 0); PG8_STAGE(PG8_SA(1, 1), a1 + hstepA, voffA);
            PG8_WAIT_L(8); PG8_BAR; PG8_WAIT_L(0); PG8_MMA(0, 0, At, B0); PG8_BAR; PG8_SCHED;
            PG8_LDB(B1, 0, 1); PG8_STAGE(PG8_SB(0, 0), b2, voffB);
            PG8_BAR; PG8_WAIT_L(0); PG8_MMA(0, 1, At, B1); PG8_BAR;
            PG8_LDA(At, 0, 1); PG8_STAGE(PG8_SA(0, 0), a2, voffA);
            PG8_BAR; PG8_WAIT_L(0); PG8_MMA(1, 0, At, B0); PG8_BAR; PG8_SCHED;
            PG8_STAGE(PG8_SB(0, 1), b2 + hstepB, voffB);
            PG8_WAIT_V(6); PG8_BAR; PG8_MMA(1, 1, At, B1); PG8_BAR;
            PG8_LDB(B0, 1, 0); PG8_SCHED; PG8_LDA(At, 1, 0); PG8_STAGE(PG8_SA(0, 1), a2 + hstepA, voffA);
            PG8_WAIT_L(8); PG8_BAR; PG8_WAIT_L(0); PG8_MMA(0, 0, At, B0); PG8_BAR; PG8_SCHED;
            PG8_LDB(B1, 1, 1); PG8_STAGE(PG8_SB(1, 0), b3, voffB);
            PG8_BAR; PG8_WAIT_L(0); PG8_MMA(0, 1, At, B1); PG8_BAR;
            PG8_LDA(At, 1, 1); PG8_STAGE(PG8_SA(1, 0), a3, voffA);
            PG8_BAR; PG8_WAIT_L(0); PG8_MMA(1, 0, At, B0); PG8_BAR; PG8_SCHED;
            PG8_STAGE(PG8_SB(1, 1), b3 + hstepB, voffB);
            PG8_WAIT_V(6); PG8_BAR; PG8_MMA(1, 1, At, B1); PG8_BAR;
            }
        }
        if constexpr (ALIGN_EPI) { if (wr == 0) PG8_BAR; }
        if constexpr (!Epi::AFTER_DRAIN) { E(acc, cur, wr, wc, fr, fq); S.done(cur); }
        if (!has_next) break;
#pragma unroll
        for (int a = 0; a < 2; ++a)
#pragma unroll
            for (int b = 0; b < 2; ++b)
#pragma unroll
                for (int m = 0; m < 4; ++m)
#pragma unroll
                    for (int n = 0; n < 2; ++n) acc[a][b][m][n] = (f32x4){0.f, 0.f, 0.f, 0.f};
        cur = nxt; cA = nA; cB = nB; ++ui;
        if constexpr (ALIGN_EPI) { if (wr == 1) PG8_BAR; }
    }
    PG8_WAIT_V(0);
    if constexpr (!ALIGN_EPI) { if (wr == 0) PG8_BAR; }
    PG8_BAR;
    if constexpr (Epi::AFTER_DRAIN) { E.fused(acc, cur, wr, wc, fr, fq, lds, wid, lane); S.done(cur); }
#undef PG8_SA
#undef PG8_SB
#undef PG8_STAGE
#undef PG8_LDA
#undef PG8_LDB
#undef PG8_MMA
#undef PG8_WAIT_V
#undef PG8_WAIT_L
#undef PG8_BAR
#undef PG8_SCHED
}
}

namespace mk {
#define LAS __attribute__((address_space(3)))
using pg8::bf16_t; using pg8::Unit; using pg8::cvt_pk_bf16;
typedef short bf16x8 __attribute__((ext_vector_type(8)));
typedef short s16x4 __attribute__((ext_vector_type(4)));
typedef float f32x4 __attribute__((ext_vector_type(4)));
typedef float f32x16 __attribute__((ext_vector_type(16)));
typedef unsigned u32x4 __attribute__((ext_vector_type(4)));
typedef unsigned u32x2 __attribute__((ext_vector_type(2)));
typedef float f32x2_t __attribute__((ext_vector_type(2)));
typedef __bf16 bf16x2_t __attribute__((ext_vector_type(2)));

constexpr int T = 65536, SEQ = 2048, D = 1024, DIN = 4120, DINP = 4352, FF = 2816, NGU = 5632;
constexpr float ALPHA = 1.189207115002721f;
constexpr float LN_EPS = 1e-5f;
constexpr float LOG2E = 1.4426950408889634f;
constexpr float QSCALE = 0.125f * LOG2E;
constexpr int NTHREADS = 512, NWAVES = 8;
constexpr int LDS_BYTES = 147456;

constexpr size_t KiB = 1024, MiB = 1u << 20;
constexpr size_t WS_CTL = 0, WS_BAR = 16 * KiB, WS_CPART = 64 * KiB, WS_CBIAS = 256 * KiB, WS_ROPE = 512 * KiB;
constexpr size_t WS_WIN = 1 * MiB, WS_WPA = 10 * MiB, WS_WPB = 11 * MiB, WS_WOUT = 12 * MiB, WS_WGU = 14 * MiB, WS_WDN = 25 * MiB;
constexpr size_t WS_CW1K = 31 * MiB, WS_CW1V = 32 * MiB, WS_CW2K = 33 * MiB, WS_CW2V = 33 * MiB + 512 * KiB;
constexpr size_t WS_H1K = 35 * MiB, WS_H1V = 39 * MiB, WS_KCMP = 43 * MiB, WS_VCMPT = 44 * MiB, WS_GN = 45 * MiB;
constexpr size_t WS_XB = 64 * MiB, WS_OA = 64 * MiB, WS_OB = 128 * MiB;
constexpr size_t WS_QA = 192 * MiB, WS_QN = 256 * MiB, WS_QNR = 320 * MiB;
constexpr size_t WS_KA = 384 * MiB, WS_VAT = 400 * MiB, WS_KC = 416 * MiB, WS_VC = 432 * MiB, WS_KSL = 448 * MiB, WS_VSLT = 464 * MiB, WS_KW = 480 * MiB, WS_VWT = 496 * MiB;
constexpr size_t WS_GM = 512 * MiB;
constexpr size_t WS_T1 = 192 * MiB, WS_Y = 320 * MiB, WS_PRE1 = 512 * MiB, WS_HF = 64 * MiB, WS_HB = 320 * MiB, WS_ACT = 448 * MiB;
constexpr size_t WS_END = 800 * MiB;

struct Params {
    const float *x, *w_in, *sinks, *pe_k, *w1_k, *b1_k, *w2_k, *pe_v, *w1_v, *b1_v, *w2_v, *wpa, *wpb, *wout, *ln1g, *ln1b, *wg, *wu, *wd, *ln2g, *ln2b;
    float* out; unsigned char* ws;
};

__device__ __forceinline__ unsigned f2bf(float f) { unsigned u = __builtin_bit_cast(unsigned, f); return (u + 0x7fffu + ((u >> 16) & 1u)) >> 16; }
__device__ __forceinline__ unsigned pk2(float lo, float hi) { f32x2_t v = {lo, hi}; bf16x2_t b = __builtin_convertvector(v, bf16x2_t); return __builtin_bit_cast(unsigned, b); }
__device__ __forceinline__ float bflo(unsigned w) { return __builtin_bit_cast(float, w << 16); }
__device__ __forceinline__ float bfhi(unsigned w) { return __builtin_bit_cast(float, w & 0xffff0000u); }
__device__ __forceinline__ float sigmoidf_(float x) { return __builtin_amdgcn_rcpf(1.f + __builtin_amdgcn_exp2f(-x * LOG2E)); }
__device__ __forceinline__ int dmap(int q) { const int i = q & 7, j = q >> 3; return (i < 4) ? (4 * j + i) : (32 + 4 * j + (i - 4)); }

__device__ __forceinline__ int win_src(int p) {
    if (p < 2048) {
        const bool il = (p < 640) || (p >= 768 && p < 1280) || (p >= 1536 && p < 1664) || (p >= 1792 && p < 1920);
        return il ? ((p & ~63) + dmap(p & 63)) : p;
    }
    if (p < 4096) return 2072 + (p - 2048);
    if (p < 4120) return 2048 + (p - 4096);
    return -1;
}

struct WinCols { const float* w; __device__ __forceinline__ const float* operator()(int p) const { const int s = win_src(p); return s < 0 ? nullptr : w + s; } };
struct IdCols { const float* w; __device__ __forceinline__ const float* operator()(int p) const { return w + p; } };
struct GuCols { const float *wg, *wu; __device__ __forceinline__ const float* operator()(int p) const { const int q = p >> 3, i = p & 7; const uintptr_t a = (uintptr_t)wg, b = (uintptr_t)wu; const uintptr_t sel = a ^ ((a ^ b) & (uintptr_t)(-(long long)(i >= 4))); return (const float*)sel + 4 * q + (i & 3); } };
struct Cw2kCols { const float* w; __device__ __forceinline__ const float* operator()(int p) const { return p < 64 ? w + dmap(p) : nullptr; } };
struct Cw2vCols { const float* w; __device__ __forceinline__ const float* operator()(int p) const { return p < 64 ? w + p : nullptr; } };

template <class F> __device__ __forceinline__ void transpose_item(const F& colfn, int ldw, int K, int nblk, bf16_t* WT, LAS float* scr, int item, int lane) {
    const int kb = item / nblk, nb = item % nblk, k0 = 64 * kb, n0 = 32 * nb;
    const float* cp = colfn(n0 + (lane & 31));
#pragma unroll 8
    for (int i = 0; i < 32; ++i) { const int kk = 2 * i + (lane >> 5); scr[kk * 33 + (lane & 31)] = cp ? cp[(size_t)(k0 + kk) * ldw] : 0.f; }
    asm volatile("s_waitcnt lgkmcnt(0)" ::: "memory");
    const int c = lane & 7;
#pragma unroll
    for (int j = 0; j < 4; ++j) { const int n = (lane >> 3) + 8 * j; const LAS float* s = scr + (8 * c) * 33 + n;
        u32x4 o; o.x = pk2(s[0 * 33], s[1 * 33]); o.y = pk2(s[2 * 33], s[3 * 33]); o.z = pk2(s[4 * 33], s[5 * 33]); o.w = pk2(s[6 * 33], s[7 * 33]);
        *(u32x4*)(WT + (size_t)(n0 + n) * K + k0 + 8 * c) = o; }
    asm volatile("s_waitcnt lgkmcnt(0)" ::: "memory");
}

__device__ __forceinline__ void p0_prologue(const Params& P, LAS unsigned char* lds, int tid, int lane, int wave) {
    unsigned char* ws = P.ws;
    LAS float* scr = (LAS float*)(lds + wave * 16384);
    const int gw = blockIdx.x * NWAVES + wave, NGW = gridDim.x * NWAVES;
    constexpr int I_IN = 16 * (DINP / 32), I_PA = 8 * 32, I_PB = 8 * 32, I_OUT = 16 * 32, I_GU = 16 * (NGU / 32), I_DN = (FF / 64) * 32, I_C1 = 32 * 8, I_C2 = 4 * 8;
    constexpr int NITEMS = I_IN + I_PA + I_PB + I_OUT + I_GU + I_DN + 2 * I_C1 + 2 * I_C2;
    for (int it = gw; it < NITEMS; it += NGW) {
        int r = it;
        if (r < I_IN) { transpose_item(WinCols{P.w_in}, DIN, 1024, DINP / 32, (bf16_t*)(ws + WS_WIN), scr, r, lane); continue; } r -= I_IN;
        if (r < I_PA) { transpose_item(IdCols{P.wpa}, 1024, 512, 32, (bf16_t*)(ws + WS_WPA), scr, r, lane); continue; } r -= I_PA;
        if (r < I_PB) { transpose_item(IdCols{P.wpb}, 1024, 512, 32, (bf16_t*)(ws + WS_WPB), scr, r, lane); continue; } r -= I_PB;
        if (r < I_OUT) { transpose_item(IdCols{P.wout}, 1024, 1024, 32, (bf16_t*)(ws + WS_WOUT), scr, r, lane); continue; } r -= I_OUT;
        if (r < I_GU) { transpose_item(GuCols{P.wg, P.wu}, FF, 1024, NGU / 32, (bf16_t*)(ws + WS_WGU), scr, r, lane); continue; } r -= I_GU;
        if (r < I_DN) { transpose_item(IdCols{P.wd}, 1024, FF, 32, (bf16_t*)(ws + WS_WDN), scr, r, lane); continue; } r -= I_DN;
        if (r < I_C1) { transpose_item(IdCols{P.w1_k}, 256, 2048, 8, (bf16_t*)(ws + WS_CW1K), scr, r, lane); continue; } r -= I_C1;
        if (r < I_C1) { transpose_item(IdCols{P.w1_v}, 256, 2048, 8, (bf16_t*)(ws + WS_CW1V), scr, r, lane); continue; } r -= I_C1;
        if (r < I_C2) { transpose_item(Cw2kCols{P.w2_k}, 64, 256, 8, (bf16_t*)(ws + WS_CW2K), scr, r, lane); continue; } r -= I_C2;
        transpose_item(Cw2vCols{P.w2_v}, 64, 256, 8, (bf16_t*)(ws + WS_CW2V), scr, r, lane);
    }
    {
        float* rc = (float*)(ws + WS_ROPE); float* rs = rc + 2048 * 32;
        for (int e = blockIdx.x * NTHREADS + tid; e < 2048 * 32; e += gridDim.x * NTHREADS) {
            const int pos = e >> 5, j = e & 31;
            const float invf = (float)exp(-(double)j * (9.210340371976184 / 32.0));
            const float ang = (float)pos * invf;
            rc[e] = (float)cos((double)ang); rs[e] = (float)sin((double)ang);
        }
    }
    if (blockIdx.x < 128 && tid < 256) {
        const int which = blockIdx.x >> 6, kc = blockIdx.x & 63, n = tid;
        const float* pe = which ? P.pe_v : P.pe_k; const float* w1 = which ? P.w1_v : P.w1_k;
        float s = 0.f;
#pragma unroll 8
        for (int i = 0; i < 32; ++i) { const int k = kc * 32 + i; s += pe[k] * w1[(size_t)k * 256 + n]; }
        ((float*)(ws + WS_CPART))[(which * 64 + kc) * 256 + n] = s;
    }
    for (int m = gw; m < T; m += NGW) {
        const f32x4* xr = (const f32x4*)(P.x + (size_t)m * D) + lane;
        u32x2* o8 = (u32x2*)((bf16_t*)(ws + WS_XB) + (size_t)m * D) + lane;
#pragma unroll
        for (int j = 0; j < 4; ++j) { const f32x4 v = xr[64 * j]; u32x2 o; o.x = pk2(v.x, v.y); o.y = pk2(v.z, v.w); o8[64 * j] = o; }
    }
}

struct EpiZ {
    static constexpr bool PERM = true, AFTER_DRAIN = false;
    unsigned char* ws;
    template <int MODE, int BJ> __device__ __forceinline__ void half(const f32x4 (&acc)[2][2][4][2], int sec, int row0, int wc, int fq) const {
        const int cb = sec * 128 + wc * 32 + 8 * fq;
        const int hc = cb & 63, j0 = (hc >> 3) * 4, g = (cb & 127) >> 6;
        size_t woff;
        if (MODE == 0) woff = WS_QA; else if (MODE == 1) woff = WS_QN;
        else if (MODE == 2) woff = sec == 4 ? WS_KA : (sec == 12 ? WS_KSL : WS_KW);
        else if (MODE == 3) woff = sec == 10 ? WS_KC : WS_VC;
        else if (MODE == 4) woff = sec == 5 ? WS_VAT : (sec == 13 ? WS_VSLT : WS_VWT);
        else if (MODE == 5) woff = WS_GM; else woff = WS_GN;
        bf16_t* dst = (bf16_t*)(ws + woff);
        const float* rc = (const float*)(ws + WS_ROPE); const float* rs = rc + 2048 * 32;
#pragma unroll
        for (int ai = 0; ai < 2; ++ai)
#pragma unroll
            for (int m = 0; m < 4; ++m) {
                const int row = row0 + ai * 128 + m * 16, pos = row & 2047, bgi = (row >> 11) * 2 + g;
                const f32x4 v0 = acc[ai][BJ][m][0], v1 = acc[ai][BJ][m][1];
                if (MODE <= 2) {
                    const f32x4 c = *(const f32x4*)(rc + pos * 32 + j0), s = *(const f32x4*)(rs + pos * 32 + j0);
                    f32x4 o1 = v0 * c - v1 * s, o2 = v1 * c + v0 * s;
                    if (MODE == 2) {
                        u32x4 w; w.x = pk2(o1[0], o1[1]); w.y = pk2(o1[2], o1[3]); w.z = pk2(o2[0], o2[1]); w.w = pk2(o2[2], o2[3]);
                        *(u32x4*)(dst + ((size_t)bgi * 2048 + pos) * 64 + hc) = w;
                    } else {
                        o1 = o1 * QSCALE; o2 = o2 * QSCALE;
                        u32x4 w; w.x = pk2(o1[0], o1[1]); w.y = pk2(o1[2], o1[3]); w.z = pk2(o2[0], o2[1]); w.w = pk2(o2[2], o2[3]);
                        if (MODE == 0) *(u32x4*)(dst + (size_t)row * 512 + cb) = w;
                        else {
                            *(u32x4*)(dst + (WS_QNR - WS_QN) / 2 + (size_t)row * 512 + (cb - 768)) = w;
                            const f32x4 a = v0 * QSCALE, b = v1 * QSCALE;
                            u32x4 w2; w2.x = pk2(a[0], a[1]); w2.y = pk2(a[2], a[3]); w2.z = pk2(b[0], b[1]); w2.w = pk2(b[2], b[3]);
                            *(u32x4*)(dst + (size_t)row * 512 + (cb - 768)) = w2;
                        }
                    }
                } else if (MODE == 3) {
                    u32x4 w; w.x = pk2(v0[0], v0[1]); w.y = pk2(v0[2], v0[3]); w.z = pk2(v1[0], v1[1]); w.w = pk2(v1[2], v1[3]);
                    *(u32x4*)(dst + ((size_t)bgi * 2048 + pos) * 64 + hc) = w;
                } else if (MODE == 4) {
                    bf16_t* p = dst + ((size_t)bgi * 64 + hc) * 2048 + pos;
#pragma unroll
                    for (int i = 0; i < 4; ++i) { p[(size_t)i * 2048] = (bf16_t)f2bf(v0[i]); p[(size_t)(4 + i) * 2048] = (bf16_t)f2bf(v1[i]); }
                } else {
                    f32x4 a, b;
#pragma unroll
                    for (int i = 0; i < 4; ++i) { a[i] = sigmoidf_(v0[i]); b[i] = sigmoidf_(v1[i]); }
                    u32x4 w; w.x = pk2(a[0], a[1]); w.y = pk2(a[2], a[3]); w.z = pk2(b[0], b[1]); w.w = pk2(b[2], b[3]);
                    if (MODE == 5) *(u32x4*)(dst + (size_t)row * 2048 + (cb - 2048)) = w;
                    else if (wc == 0) *(u32x4*)(dst + (size_t)row * 32 + 8 * fq) = w;
                }
            }
    }
    __device__ __forceinline__ void operator()(const f32x4 (&acc)[2][2][4][2], const Unit& u, int wr, int wc, int fr, int fq) const {
        const int row0 = u.pm * 256 + wr * 64 + fr;
        both<0>(acc, u.pn * 2, row0, wc, fq); both<1>(acc, u.pn * 2 + 1, row0, wc, fq);
    }
    template <int BJ> __device__ __forceinline__ void both(const f32x4 (&acc)[2][2][4][2], int sec, int row0, int wc, int fq) const {
        if (sec < 4) half<0, BJ>(acc, sec, row0, wc, fq);
        else if (sec == 4 || sec == 12 || sec == 14) half<2, BJ>(acc, sec, row0, wc, fq);
        else if (sec == 5 || sec == 13 || sec == 15) half<4, BJ>(acc, sec, row0, wc, fq);
        else if (sec < 10) half<1, BJ>(acc, sec, row0, wc, fq);
        else if (sec < 12) half<3, BJ>(acc, sec, row0, wc, fq);
        else if (sec < 32) half<5, BJ>(acc, sec, row0, wc, fq);
        else if (sec == 32) half<6, BJ>(acc, sec, row0, wc, fq);
    }
};

struct EpiC1 {
    static constexpr bool PERM = true, AFTER_DRAIN = false;
    bf16_t* O; const float* bias;
    __device__ __forceinline__ void operator()(const f32x4 (&acc)[2][2][4][2], const Unit& u, int wr, int wc, int fr, int fq) const {
        const int row0 = u.pm * 256 + wr * 64 + fr;
#pragma unroll
        for (int bj = 0; bj < 2; ++bj) {
            const int col = bj * 128 + wc * 32 + 8 * fq;
            const f32x4 b0 = *(const f32x4*)(bias + col), b1 = *(const f32x4*)(bias + col + 4);
#pragma unroll
            for (int ai = 0; ai < 2; ++ai)
#pragma unroll
                for (int m = 0; m < 4; ++m) {
                    const int row = row0 + ai * 128 + m * 16;
                    f32x4 v0 = acc[ai][bj][m][0] + b0, v1 = acc[ai][bj][m][1] + b1;
#pragma unroll
                    for (int i = 0; i < 4; ++i) {
                        { const float x = v0[i], uu = 0.7978845608028654f * (x + 0.044715f * x * x * x); v0[i] = x * sigmoidf_(2.f * uu); }
                        { const float x = v1[i], uu = 0.7978845608028654f * (x + 0.044715f * x * x * x); v1[i] = x * sigmoidf_(2.f * uu); }
                    }
                    u32x4 w; w.x = pk2(v0[0], v0[1]); w.y = pk2(v0[2], v0[3]); w.z = pk2(v1[0], v1[1]); w.w = pk2(v1[2], v1[3]);
                    *(u32x4*)(O + (size_t)row * 256 + col) = w;
                }
        }
    }
};
struct EpiC2 {
    static constexpr bool PERM = true, AFTER_DRAIN = false;
    bf16_t* O; int transposed;
    __device__ __forceinline__ void operator()(const f32x4 (&acc)[2][2][4][2], const Unit& u, int wr, int wc, int fr, int fq) const {
        if (wc >= 2) return;
        const int row0 = u.pm * 256 + wr * 64 + fr, col = wc * 32 + 8 * fq;
#pragma unroll
        for (int ai = 0; ai < 2; ++ai)
#pragma unroll
            for (int m = 0; m < 4; ++m) {
                const int row = row0 + ai * 128 + m * 16;
                const f32x4 v0 = acc[ai][0][m][0], v1 = acc[ai][0][m][1];
                if (!transposed) {
                    u32x4 w; w.x = pk2(v0[0], v0[1]); w.y = pk2(v0[2], v0[3]); w.z = pk2(v1[0], v1[1]); w.w = pk2(v1[2], v1[3]);
                    *(u32x4*)(O + (size_t)row * 64 + col) = w;
                } else {
                    bf16_t* p = O + ((size_t)(row >> 7) * 64 + col) * 128 + (row & 127);
#pragma unroll
                    for (int i = 0; i < 4; ++i) { p[i * 128] = (bf16_t)f2bf(v0[i]); p[(4 + i) * 128] = (bf16_t)f2bf(v1[i]); }
                }
            }
    }
};
template <bool SECOND> struct EpiProj {
    static constexpr bool PERM = true, AFTER_DRAIN = false;
    const bf16_t* gm; const bf16_t* t1; bf16_t* O;
    __device__ __forceinline__ void operator()(const f32x4 (&acc)[2][2][4][2], const Unit& u, int wr, int wc, int fr, int fq) const {
        const int row0 = u.pm * 256 + wr * 64 + fr;
#pragma unroll
        for (int bj = 0; bj < 2; ++bj) {
            const int col = u.pn * 256 + bj * 128 + wc * 32 + 8 * fq;
#pragma unroll
            for (int ai = 0; ai < 2; ++ai)
#pragma unroll
                for (int m = 0; m < 4; ++m) {
                    const size_t row = (size_t)(row0 + ai * 128 + m * 16);
                    const u32x4 gw = *(const u32x4*)(gm + row * 2048 + (SECOND ? 1024 : 0) + col);
                    const f32x4 v0 = acc[ai][bj][m][0], v1 = acc[ai][bj][m][1];
                    float r[8] = {v0[0] * bflo(gw.x), v0[1] * bfhi(gw.x), v0[2] * bflo(gw.y), v0[3] * bfhi(gw.y), v1[0] * bflo(gw.z), v1[1] * bfhi(gw.z), v1[2] * bflo(gw.w), v1[3] * bfhi(gw.w)};
                    if (SECOND) {
                        const u32x4 tw = *(const u32x4*)(t1 + row * 1024 + col);
                        r[0] += bflo(tw.x); r[1] += bfhi(tw.x); r[2] += bflo(tw.y); r[3] += bfhi(tw.y); r[4] += bflo(tw.z); r[5] += bfhi(tw.z); r[6] += bflo(tw.w); r[7] += bfhi(tw.w);
                    }
                    u32x4 w; w.x = pk2(r[0], r[1]); w.y = pk2(r[2], r[3]); w.z = pk2(r[4], r[5]); w.w = pk2(r[6], r[7]);
                    *(u32x4*)(O + row * 1024 + col) = w;
                }
        }
    }
};
struct EpiRes {
    static constexpr bool PERM = false, AFTER_DRAIN = false;
    const float* base; float* out;
    __device__ __forceinline__ void operator()(const f32x4 (&acc)[2][2][4][2], const Unit& u, int wr, int wc, int fr, int fq) const {
        const int row0 = u.pm * 256 + wr * 64 + fr, col0 = u.pn * 256 + wc * 32 + 4 * fq;
#pragma unroll
        for (int ai = 0; ai < 2; ++ai)
#pragma unroll
            for (int m = 0; m < 4; ++m) {
                const size_t off = (size_t)(row0 + ai * 128 + m * 16) * 1024 + col0;
#pragma unroll
                for (int bj = 0; bj < 2; ++bj)
#pragma unroll
                    for (int n = 0; n < 2; ++n) { const f32x4 b = *(const f32x4*)(base + off + bj * 128 + n * 16); *(f32x4*)(out + off + bj * 128 + n * 16) = b * ALPHA + acc[ai][bj][m][n]; }
            }
    }
};
struct EpiGU {
    static constexpr bool PERM = true, AFTER_DRAIN = false;
    bf16_t* O;
    __device__ __forceinline__ void operator()(const f32x4 (&acc)[2][2][4][2], const Unit& u, int wr, int wc, int fr, int fq) const {
        const int row0 = u.pm * 256 + wr * 64 + fr;
#pragma unroll
        for (int bj = 0; bj < 2; ++bj) {
            const int hcol = (u.pn * 256 + bj * 128 + wc * 32 + 8 * fq) >> 1;
#pragma unroll
            for (int ai = 0; ai < 2; ++ai)
#pragma unroll
                for (int m = 0; m < 4; ++m) {
                    const size_t row = (size_t)(row0 + ai * 128 + m * 16);
                    const f32x4 g = acc[ai][bj][m][0], up = acc[ai][bj][m][1];
                    float a[4];
#pragma unroll
                    for (int i = 0; i < 4; ++i) a[i] = g[i] * sigmoidf_(g[i]) * up[i];
                    u32x2 w; w.x = pk2(a[0], a[1]); w.y = pk2(a[2], a[3]);
                    *(u32x2*)(O + row * FF + hcol) = w;
                }
        }
    }
};

template <bool WRITE_BF> __device__ __forceinline__ void ln_phase(const float* in, float* outf, bf16_t* outb, const float* gam, const float* bet, int lane, int wave) {
    const int gw = blockIdx.x * NWAVES + wave, NGW = gridDim.x * NWAVES;
    f32x4 gv[4], bv[4];
#pragma unroll
    for (int j = 0; j < 4; ++j) { gv[j] = ((const f32x4*)gam)[lane + 64 * j]; bv[j] = ((const f32x4*)bet)[lane + 64 * j]; }
    for (int m = gw; m < T; m += NGW) {
        const f32x4* xr = (const f32x4*)(in + (size_t)m * D) + lane;
        f32x4 v[4]; float s = 0.f;
#pragma unroll
        for (int j = 0; j < 4; ++j) { v[j] = xr[64 * j]; s += (v[j].x + v[j].y) + (v[j].z + v[j].w); }
#pragma unroll
        for (int o = 1; o < 64; o <<= 1) s += __shfl_xor(s, o);
        const float mean = s * (1.f / D); float s2 = 0.f;
#pragma unroll
        for (int j = 0; j < 4; ++j) { v[j] = v[j] - mean; s2 += (v[j].x * v[j].x + v[j].y * v[j].y) + (v[j].z * v[j].z + v[j].w * v[j].w); }
#pragma unroll
        for (int o = 1; o < 64; o <<= 1) s2 += __shfl_xor(s2, o);
        const float rstd = 1.f / sqrtf(s2 * (1.f / D) + LN_EPS);
        f32x4* of = (f32x4*)(outf + (size_t)m * D) + lane;
#pragma unroll
        for (int j = 0; j < 4; ++j) {
            const f32x4 y = v[j] * rstd * gv[j] + bv[j];
            of[64 * j] = y;
            if (WRITE_BF) { u32x2 o; o.x = pk2(y.x, y.y); o.y = pk2(y.z, y.w); ((u32x2*)(outb + (size_t)m * D))[lane + 64 * j] = o; }
        }
    }
}

#define GAS __attribute__((address_space(1)))
#define LDS_BARRIER() do { asm volatile("s_waitcnt lgkmcnt(0)" ::: "memory"); __builtin_amdgcn_s_barrier(); asm volatile("" ::: "memory"); } while (0)
#define MFMA32(a, b, c) __builtin_amdgcn_mfma_f32_32x32x16_bf16((a), (b), (c), 0, 0, 0)
constexpr int SLOT_BYTES = 16384, L_IMPW = 65536, L_IMPS = 99328, L_SEL = 107776, L_MISC = 108032;
#ifdef PROBE_A2
constexpr unsigned NITEMS_Q = 6144u;
#else
constexpr unsigned NITEMS_Q = 4096u;
#endif
#define WAIT_VM(n) asm volatile("s_waitcnt vmcnt(" #n ")" ::: "memory")
constexpr float NEG_INF = -__builtin_inff();
__device__ __forceinline__ int crow(int r, int h) { return (r & 3) + 8 * (r >> 2) + 4 * h; }
__device__ __forceinline__ void tile_dma(const bf16_t* kt, const bf16_t* vt, int vstride, LAS unsigned char* slot, int wave, int lane) {
    const int row = wave * 8 + (lane >> 3), c = (lane & 7) ^ ((row >> 1) & 7);
    __builtin_amdgcn_global_load_lds((const unsigned*)(kt + row * 64 + c * 8), (LAS unsigned*)(slot + wave * 1024), 16, 0, 0);
    __builtin_amdgcn_global_load_lds((const unsigned*)(vt + (size_t)row * vstride + c * 8), (LAS unsigned*)(slot + 8192 + wave * 1024), 16, 0, 0);
}
#define SCHED_FENCE() __builtin_amdgcn_sched_barrier(0)
__device__ __forceinline__ float xor32_max(float x) { const unsigned u = __builtin_bit_cast(unsigned, x); const auto r = __builtin_amdgcn_permlane32_swap(u, u, false, false); return fmaxf(__builtin_bit_cast(float, (unsigned)r[0]), __builtin_bit_cast(float, (unsigned)r[1])); }
__device__ __forceinline__ float xor32_sum(float x) { const unsigned u = __builtin_bit_cast(unsigned, x); const auto r = __builtin_amdgcn_permlane32_swap(u, u, false, false); return __builtin_bit_cast(float, (unsigned)r[0]) + __builtin_bit_cast(float, (unsigned)r[1]); }
__device__ __forceinline__ void tile_kread(bf16x8 (&kf)[8], const LAS unsigned char* kb, int q, int g) {
    const LAS unsigned char* a = kb + q * 128; const int f = (q >> 1) & 7;
#pragma unroll
    for (int ks = 0; ks < 4; ++ks) { const int off = ((2 * ks + g) ^ f) * 16; kf[2 * ks] = *(const LAS bf16x8*)(a + off); kf[2 * ks + 1] = *(const LAS bf16x8*)(a + 32 * 128 + off); }
}
__device__ __forceinline__ void tile_qk_mfma(f32x16& p0, f32x16& p1, const bf16x8 (&kf)[8], const bf16x8 (&qf)[4]) {
#pragma unroll
    for (int i = 0; i < 16; ++i) { p0[i] = 0.f; p1[i] = 0.f; }
#pragma unroll
    for (int ks = 0; ks < 4; ++ks) { p0 = MFMA32(kf[2 * ks], qf[ks], p0); p1 = MFMA32(kf[2 * ks + 1], qf[ks], p1); }
}
__device__ __forceinline__ void tile_vread(bf16x8 (&vf)[8], const LAS unsigned char* vb, int q, int g) {
#pragma unroll
    for (int h2 = 0; h2 < 2; ++h2)
#pragma unroll
        for (int s = 0; s < 2; ++s)
#pragma unroll
            for (int dt = 0; dt < 2; ++dt) {
                const LAS unsigned char* vr = vb + (32 * dt + q) * 128 + 8 * g; const int f = (q >> 1) & 7, c = 4 * h2 + 2 * s;
                const u32x2 lo = *(const LAS u32x2*)(vr + ((c ^ f) * 16)), hi = *(const LAS u32x2*)(vr + (((c + 1) ^ f) * 16));
                const u32x4 vw = {lo.x, lo.y, hi.x, hi.y};
                vf[h2 * 4 + s * 2 + dt] = __builtin_bit_cast(bf16x8, vw);
            }
}
__device__ __forceinline__ void tile_pv_mfma(f32x16 (&o)[2], const f32x16& p, int h2, const bf16x8 (&vf)[8]) {
#pragma unroll
    for (int s = 0; s < 2; ++s) {
        u32x4 pw; pw.x = pk2(p[8 * s], p[8 * s + 1]); pw.y = pk2(p[8 * s + 2], p[8 * s + 3]); pw.z = pk2(p[8 * s + 4], p[8 * s + 5]); pw.w = pk2(p[8 * s + 6], p[8 * s + 7]);
        const bf16x8 pf = __builtin_bit_cast(bf16x8, pw);
#pragma unroll
        for (int dt = 0; dt < 2; ++dt) o[dt] = MFMA32(h2 ? vf[4 + s * 2 + dt] : vf[s * 2 + dt], pf, o[dt]);
    }
}
__device__ __forceinline__ void softmax_update(f32x16& p0, f32x16& p1, float& m, float& l, f32x16 (&o)[2]) {
    float mx = fmaxf(p0[0], p1[0]);
#pragma unroll
    for (int i = 1; i < 16; ++i) mx = fmaxf(mx, fmaxf(p0[i], p1[i]));
    mx = xor32_max(mx);
    const float mn = fmaxf(m, mx), mu = (mn == NEG_INF) ? 0.f : mn;
    const float alpha = __builtin_amdgcn_exp2f(m - mu);
    m = mn;
    float rs = 0.f;
#pragma unroll
    for (int i = 0; i < 16; ++i) { p0[i] = __builtin_amdgcn_exp2f(p0[i] - mu); p1[i] = __builtin_amdgcn_exp2f(p1[i] - mu); rs += p0[i] + p1[i]; }
    l = l * alpha + rs;
    o[0] = o[0] * alpha; o[1] = o[1] * alpha;
}
__device__ __forceinline__ void zero_o(f32x16 (&o)[2]) {
#pragma unroll
    for (int i = 0; i < 16; ++i) { o[0][i] = 0.f; o[1][i] = 0.f; }
}
template <bool SEL> __device__ __forceinline__ void tile_compute(f32x16 (&o)[2], float& m, float& l, const bf16x8 (&qf)[4], const LAS unsigned char* kb, const LAS unsigned char* vb,
                                                                 int j, int jlow, int jdiag, unsigned selbits, int q, int g, int tok) {
    f32x16 p0, p1;
    { bf16x8 kf[8]; tile_kread(kf, kb, q, g); SCHED_FENCE(); tile_qk_mfma(p0, p1, kf, qf); SCHED_FENCE(); }
    bf16x8 vf[8]; tile_vread(vf, vb, q, g); SCHED_FENCE();
    if (SEL) { if (!((selbits >> j) & 1u)) {
#pragma unroll
        for (int i = 0; i < 16; ++i) { p0[i] = NEG_INF; p1[i] = NEG_INF; } } }
    if (j == jdiag) {
#pragma unroll
        for (int i = 0; i < 16; ++i) { const int kv = crow(i, g); if (kv > tok) p0[i] = NEG_INF; if (kv + 32 > tok) p1[i] = NEG_INF; }
    }
    if (j == jlow) {
#pragma unroll
        for (int i = 0; i < 16; ++i) { const int kv = crow(i, g); if (kv <= tok) p0[i] = NEG_INF; if (kv + 32 <= tok) p1[i] = NEG_INF; }
    }
    softmax_update(p0, p1, m, l, o);
    tile_pv_mfma(o, p0, 0, vf); tile_pv_mfma(o, p1, 1, vf);
}
template <bool SEL> __device__ __forceinline__ void stream_pass(f32x16 (&o)[2], float& m, float& l, const bf16x8 (&qf)[4], const bf16_t* kbase, const bf16_t* vtbase,
                                                                unsigned tilemask, int jlow, int jdiag, unsigned selbits, LAS unsigned char* lds, int wave, int lane, int q, int g, int tok) {
    unsigned rem = tilemask;
    const int n = __builtin_popcount(tilemask);
    WAIT_VM(0);
    int jq0 = __builtin_ctz(rem), jq1 = 0, jq2 = 0; rem &= rem - 1;
    tile_dma(kbase + (size_t)jq0 * 4096, vtbase + jq0 * 64, 2048, lds, wave, lane);
    if (n > 1) { jq1 = __builtin_ctz(rem); rem &= rem - 1; tile_dma(kbase + (size_t)jq1 * 4096, vtbase + jq1 * 64, 2048, lds + SLOT_BYTES, wave, lane); }
    if (n > 2) { jq2 = __builtin_ctz(rem); rem &= rem - 1; tile_dma(kbase + (size_t)jq2 * 4096, vtbase + jq2 * 64, 2048, lds + 2 * SLOT_BYTES, wave, lane); }
    for (int i = 0; i < n; ++i) {
        const int ahead = n - 1 - i;
        if (ahead >= 2) WAIT_VM(4); else if (ahead == 1) WAIT_VM(2); else WAIT_VM(0);
        LDS_BARRIER();
        int jq3 = 0;
        if (i + 3 < n) { jq3 = __builtin_ctz(rem); rem &= rem - 1; tile_dma(kbase + (size_t)jq3 * 4096, vtbase + jq3 * 64, 2048, lds + ((i + 3) & 3) * SLOT_BYTES, wave, lane); }
        const LAS unsigned char* sl = lds + (i & 3) * SLOT_BYTES;
        tile_compute<SEL>(o, m, l, qf, sl, sl + 8192, jq0, jlow, jdiag, selbits, q, g, tok);
        jq0 = jq1; jq1 = jq2; jq2 = jq3;
    }
    LDS_BARRIER();
}
__device__ __forceinline__ void imp_sub(const f32x16& p, int st, float& carry, LAS float* row, int g) {
#pragma unroll
    for (int a = 0; a < 4; ++a) {
        const float bsum = (p[4 * a] + p[4 * a + 1]) + (p[4 * a + 2] + p[4 * a + 3]), last = p[4 * a + 3];
        const float recv = __shfl_xor(last, 32);
        row[8 * st + 2 * a + g] = bsum + (g ? recv : carry);
        carry = recv;
    }
}
__device__ __forceinline__ void load_q(bf16x8 (&qf)[4], const bf16_t* qrow, int g) {
#pragma unroll
    for (int ks = 0; ks < 4; ++ks) qf[ks] = *(const GAS bf16x8*)(qrow + 16 * ks + 8 * g);
    asm volatile("" : "+v"(qf[0]), "+v"(qf[1]), "+v"(qf[2]), "+v"(qf[3]));
}
__device__ __forceinline__ void store_o(const f32x16 (&o)[2], bf16_t* orow, int g) {
#pragma unroll
    for (int dt = 0; dt < 2; ++dt)
#pragma unroll
        for (int a = 0; a < 4; ++a) { u32x2 w; w.x = pk2(o[dt][4 * a], o[dt][4 * a + 1]); w.y = pk2(o[dt][4 * a + 2], o[dt][4 * a + 3]); *(GAS u32x2*)(orow + 32 * dt + 8 * a + 4 * g) = w; }
}

__device__ __forceinline__ unsigned next_item(unsigned* ctr, unsigned& curq, unsigned& tried) {
    while (tried < 8u) {
        const unsigned i = __hip_atomic_fetch_add((GAS unsigned*)(ctr + 16 * curq), 1u, __ATOMIC_RELAXED, __HIP_MEMORY_SCOPE_AGENT);
        if (i < 512u) return curq * 512u + i;
        curq = (curq + 1u) & 7u; ++tried;
    }
    return 0xffffffffu;
}
__device__ __forceinline__ void attn_phase(const Params& P, LAS unsigned char* lds, int cidx = 0) {
    unsigned* counter = (unsigned*)(P.ws + WS_CTL) + 128 * cidx;
    unsigned curq = (unsigned)__builtin_amdgcn_s_getreg((3 << 11) | 20) & 7u, tried = 0u;
    bool first = true;
    for (;;) {
        int tid = threadIdx.x; asm volatile("" : "+v"(tid));
        const int lane = tid & 63, wave = __builtin_amdgcn_readfirstlane(tid >> 6);
        const int q = lane & 31, g = lane >> 5, hh = wave >> 1, tok = (wave & 1) * 32 + q;
        if (first) { if (tid == 0) *(LAS unsigned*)(lds + L_MISC) = next_item(counter, curq, tried); first = false; }
        LDS_BARRIER();
        const unsigned idx = *(volatile LAS unsigned*)(lds + L_MISC);
        LDS_BARRIER();
        if (idx == 0xffffffffu) break;
        unsigned nextidx = 0u; if (tid == 0) nextidx = next_item(counter, curq, tried);
        unsigned char* ws = P.ws; asm volatile("" : "+s"(ws));
        const int xq = (int)(idx >> 9), li = (int)(idx & 511u); const bool isB = li < 256;
        const int qb = 31 - (li & 31), bg = xq * 8 + ((li >> 5) & 7);
        const int b = bg >> 1, gkv = bg & 1, head = gkv * 4 + hh;
        const size_t trow = (size_t)b * 2048 + qb * 64 + tok;
        bf16x8 qf[4]; f32x16 o[2];
        if (!isB) {
            load_q(qf, (const bf16_t*)(ws + WS_QA) + trow * 512 + head * 64, g);
            float m = ((const GAS float*)P.sinks)[head] * LOG2E, l = 0.5f; zero_o(o);
            asm volatile("" : "+v"(m));
            const int lo = qb >= 2 ? qb - 2 : 0;
            const unsigned tm = ((2u << qb) - 1u) & ~((1u << lo) - 1u);
            stream_pass<false>(o, m, l, qf, (const bf16_t*)(ws + WS_KA) + (size_t)bg * 2048 * 64, (const bf16_t*)(ws + WS_VAT) + (size_t)bg * 64 * 2048, tm, qb - 2, qb, 0u, lds, wave, lane, q, g, tok);
            const float lt = xor32_sum(l), inv = 1.f / lt;
            o[0] = o[0] * inv; o[1] = o[1] * inv;
            store_o(o, (bf16_t*)(ws + WS_OA) + trow * 512 + head * 64, g);
        } else {
            f32x16 acc[2];
            const GAS bf16_t* gnp = (const GAS bf16_t*)(ws + WS_GN) + trow * 32 + head;
            float g0 = bflo((unsigned)gnp[0]), g1 = bflo((unsigned)gnp[8]), g2 = bflo((unsigned)gnp[16]);
            asm volatile("" : "+v"(g0), "+v"(g1), "+v"(g2));
            {
                load_q(qf, (const bf16_t*)(ws + WS_QN) + trow * 512 + head * 64, g);
                const bf16_t* kc = (const bf16_t*)(ws + WS_KCMP) + (size_t)bg * 128 * 64; const bf16_t* vct = (const bf16_t*)(ws + WS_VCMPT) + (size_t)bg * 64 * 128;
                const bool two = qb >= 16;
                tile_dma(kc, vct, 128, lds, wave, lane); if (two) tile_dma(kc + 64 * 64, vct + 64, 128, lds + SLOT_BYTES, wave, lane);
                WAIT_VM(0); LDS_BARRIER();
                f32x16 p0, p1, p2, p3;
                { bf16x8 kf[8]; tile_kread(kf, lds, q, g); SCHED_FENCE(); tile_qk_mfma(p0, p1, kf, qf); SCHED_FENCE(); }
                if (two) { bf16x8 kf[8]; tile_kread(kf, lds + SLOT_BYTES, q, g); SCHED_FENCE(); tile_qk_mfma(p2, p3, kf, qf); SCHED_FENCE(); }
                else {
#pragma unroll
                    for (int i = 0; i < 16; ++i) { p2[i] = NEG_INF; p3[i] = NEG_INF; } }
                const int cmax = (qb * 64 + tok - 31) >> 4;
                float mx = NEG_INF;
#pragma unroll
                for (int i = 0; i < 16; ++i) { const int c = crow(i, g);
                    if (c > cmax) p0[i] = NEG_INF; if (c + 32 > cmax) p1[i] = NEG_INF; if (c + 64 > cmax) p2[i] = NEG_INF; if (c + 96 > cmax) p3[i] = NEG_INF;
                    mx = fmaxf(fmaxf(mx, fmaxf(p0[i], p1[i])), fmaxf(p2[i], p3[i])); }
                mx = xor32_max(mx);
                const float mu = (mx == NEG_INF) ? 0.f : mx;
                float rs = 0.f;
#pragma unroll
                for (int i = 0; i < 16; ++i) { p0[i] = __builtin_amdgcn_exp2f(p0[i] - mu); p1[i] = __builtin_amdgcn_exp2f(p1[i] - mu); p2[i] = __builtin_amdgcn_exp2f(p2[i] - mu); p3[i] = __builtin_amdgcn_exp2f(p3[i] - mu);
                    rs += (p0[i] + p1[i]) + (p2[i] + p3[i]); }
                rs = xor32_sum(rs);
                const float inv = rs > 0.f ? 1.f / rs : 0.f;
                p0 = p0 * inv; p1 = p1 * inv; p2 = p2 * inv; p3 = p3 * inv;
                LAS float* irow = (LAS float*)(lds + L_IMPW) + (hh * 64 + tok) * 33;
                float carry = 0.f;
                imp_sub(p0, 0, carry, irow, g); imp_sub(p1, 1, carry, irow, g); imp_sub(p2, 2, carry, irow, g); imp_sub(p3, 3, carry, irow, g);
                zero_o(o);
                { bf16x8 vf[8]; tile_vread(vf, lds + 8192, q, g); SCHED_FENCE(); tile_pv_mfma(o, p0, 0, vf); tile_pv_mfma(o, p1, 1, vf); }
                if (two) { bf16x8 vf[8]; tile_vread(vf, lds + SLOT_BYTES + 8192, q, g); SCHED_FENCE(); tile_pv_mfma(o, p2, 0, vf); tile_pv_mfma(o, p3, 1, vf); }
                acc[0] = o[0] * g0; acc[1] = o[1] * g0;
                LDS_BARRIER();
            }
            unsigned selbits, uni;
            {
                const int tk = tid >> 3, jj = tid & 7;
                const LAS float* iw = (const LAS float*)(lds + L_IMPW); LAS float* is = (LAS float*)(lds + L_IMPS);
#pragma unroll
                for (int k = 0; k < 4; ++k) { const int j = jj + 8 * k;
                    is[tk * 33 + j] = ((iw[(0 * 64 + tk) * 33 + j] + iw[(1 * 64 + tk) * 33 + j]) + iw[(2 * 64 + tk) * 33 + j]) + iw[(3 * 64 + tk) * 33 + j]; }
                LDS_BARRIER();
                unsigned part = 0u;
                if (qb <= 15) {
#pragma unroll
                    for (int k = 0; k < 4; ++k) { const int j = jj + 8 * k; if (j <= qb) part |= 1u << j; }
                } else {
#pragma unroll
                    for (int k = 0; k < 4; ++k) { const int j = jj + 8 * k; bool sel;
                        if (j == 0 || j == qb || j == qb - 1) sel = true;
                        else if (j > qb) sel = false;
                        else { const float v = is[tk * 33 + j]; int rank = 0;
                            for (int j2 = 1; j2 <= qb - 2; ++j2) { const float v2 = is[tk * 33 + j2]; rank += (v2 > v || (v2 == v && j2 < j)) ? 1 : 0; }
                            sel = rank < 13; }
                        if (sel) part |= 1u << j; }
                }
                part |= __shfl_xor(part, 1); part |= __shfl_xor(part, 2); part |= __shfl_xor(part, 4);
                if (jj == 0) *(LAS unsigned*)(lds + L_SEL + 4 * tk) = part;
                LDS_BARRIER();
                selbits = *(const LAS unsigned*)(lds + L_SEL + 4 * tok);
                uni = *(const LAS unsigned*)(lds + L_SEL + 4 * lane);
#pragma unroll
                for (int s = 1; s < 64; s <<= 1) uni |= __shfl_xor(uni, s);
                uni = __builtin_amdgcn_readfirstlane(uni);
            }
            load_q(qf, (const bf16_t*)(ws + WS_QNR) + trow * 512 + head * 64, g);
            {
                float m = NEG_INF, l = 0.f; zero_o(o);
                const unsigned tm = uni & ((2u << qb) - 1u);
                stream_pass<true>(o, m, l, qf, (const bf16_t*)(ws + WS_KSL) + (size_t)bg * 2048 * 64, (const bf16_t*)(ws + WS_VSLT) + (size_t)bg * 64 * 2048, tm, -1, qb, selbits, lds, wave, lane, q, g, tok);
                const float lt = xor32_sum(l), sc = g1 / lt;
                acc[0] = acc[0] + o[0] * sc; acc[1] = acc[1] + o[1] * sc;
            }
            {
                float m = NEG_INF, l = 0.f; zero_o(o);
                const int lo = qb >= 8 ? qb - 8 : 0;
                const unsigned tm = ((2u << qb) - 1u) & ~((1u << lo) - 1u);
                stream_pass<false>(o, m, l, qf, (const bf16_t*)(ws + WS_KW) + (size_t)bg * 2048 * 64, (const bf16_t*)(ws + WS_VWT) + (size_t)bg * 64 * 2048, tm, qb - 8, qb, 0u, lds, wave, lane, q, g, tok);
                const float lt = xor32_sum(l), sc = g2 / lt;
                acc[0] = acc[0] + o[0] * sc; acc[1] = acc[1] + o[1] * sc;
            }
            store_o(acc, (bf16_t*)(ws + WS_OB) + trow * 512 + head * 64, g);
        }
        if (tid == 0) *(LAS unsigned*)(lds + L_MISC) = nextidx;
    }
}
#define XB_TMO      128
#define XB_XCNT(j)  (256  + 64 * (j))
#define XB_XSUB(j)  (1280 + 64 * (j))
#define XB_XGEN(j)  (2304 + 64 * (j))
#define XB_TOP      3328
#define XB_TOPGEN   3392
#define XCD_BAR_WORDS 3456
#define XB_SPIN_CAP (1u << 18)

__device__ __forceinline__ unsigned xb_ld(unsigned* p)              { return __hip_atomic_load(p, __ATOMIC_RELAXED, __HIP_MEMORY_SCOPE_AGENT); }
__device__ __forceinline__ unsigned xb_add(unsigned* p, unsigned v) { return __hip_atomic_fetch_add(p, v, __ATOMIC_RELAXED, __HIP_MEMORY_SCOPE_AGENT); }
__device__ __forceinline__ unsigned xb_xcc_id() { return (unsigned)__builtin_amdgcn_s_getreg((3 << 11) | 20) & 0xFu; }
#define XB_SPIN(cond, bar) do { unsigned _sp = 0; while (cond) { __builtin_amdgcn_s_sleep(1); \
    if ((++_sp & 255u) == 0u) { if (xb_ld(&(bar)[XB_TMO])) break; if (_sp > XB_SPIN_CAP) { atomicAdd(&(bar)[XB_TMO], 1u); break; } } } } while (0)

struct XcdBarrier {
    unsigned* bar; unsigned x;
    volatile LAS unsigned* st;
};

__device__ __forceinline__ XcdBarrier xcd_barrier_post(unsigned* bar, volatile LAS unsigned* st) {
    XcdBarrier b; b.bar = bar; b.x = xb_xcc_id(); b.st = st;
    if (threadIdx.x == 0) (void)xb_add(&bar[XB_XCNT(b.x)], 1u);
    return b;
}
__device__ __forceinline__ void xcd_barrier_complete(unsigned* bar, unsigned x, unsigned& nloc, unsigned& nx) {
    const unsigned G = gridDim.x * gridDim.y * gridDim.z;
    unsigned sum, cnt, mine, sp = 0u;
    for (;;) {
        sum = 0u; cnt = 0u; mine = 0u;
#pragma unroll
        for (unsigned j = 0; j < 16; ++j) { const unsigned c = xb_ld(&bar[XB_XCNT(j)]); sum += c; cnt += (c > 0u) ? 1u : 0u; mine = (j == x) ? c : mine; }
        if (sum == G) break;
        __builtin_amdgcn_s_sleep(1);
        if ((++sp & 255u) == 0u) { if (xb_ld(&bar[XB_TMO])) break; if (sp > XB_SPIN_CAP) { atomicAdd(&bar[XB_TMO], 1u); break; } }
    }
    nloc = mine > 0u ? mine : 1u; nx = cnt > 0u ? cnt : 1u;
}

__device__ __forceinline__ void xcd_barrier(const XcdBarrier& b) {
    asm volatile("s_waitcnt vmcnt(0)" ::: "memory");
    __syncthreads();
    if (threadIdx.x == 0) {
        unsigned* bar = b.bar;
        __builtin_amdgcn_s_waitcnt(0);
        unsigned nloc = b.st[0], nx = b.st[1];
        if (nloc == 0u) { xcd_barrier_complete(bar, b.x, nloc, nx); b.st[0] = nloc; b.st[1] = nx; }
        const unsigned old = xb_add(&bar[XB_XSUB(b.x)], 1u);
        const unsigned gen = old / nloc;
        if (old + 1u == (gen + 1u) * nloc) {
            __builtin_amdgcn_fence(__ATOMIC_RELEASE, "agent");
            asm volatile("s_waitcnt vmcnt(0)" ::: "memory");
            const unsigned og = xb_add(&bar[XB_TOP], 1u);
            const unsigned tg = og / nx;
            if (og + 1u == (tg + 1u) * nx) xb_add(&bar[XB_TOPGEN], 1u);
            else XB_SPIN(xb_ld(&bar[XB_TOPGEN]) == tg, bar);
            __builtin_amdgcn_fence(__ATOMIC_ACQUIRE, "agent");
            xb_add(&bar[XB_XGEN(b.x)], 1u);
            asm volatile("s_waitcnt vmcnt(0)" ::: "memory");
        } else {
            XB_SPIN(xb_ld(&bar[XB_XGEN(b.x)]) == gen, bar);
            __builtin_amdgcn_fence(__ATOMIC_ACQUIRE, "agent");
            asm volatile("s_waitcnt vmcnt(0)" ::: "memory");
        }
    }
    __syncthreads();
}


#ifndef MK_PHASE_HI
#define MK_PHASE_HI 99
#endif
__global__ void __launch_bounds__(NTHREADS, 2) fwd_megakernel(Params P) {
    extern __shared__ __attribute__((aligned(16))) unsigned char lds_raw[];
    LAS unsigned char* lds = (LAS unsigned char*)lds_raw;
    cg::grid_group grid = cg::this_grid();
    volatile LAS unsigned* bst = (volatile LAS unsigned*)(lds + LDS_BYTES - 16);
    if (threadIdx.x == 0) { bst[0] = 0u; bst[1] = 0u; }
    const XcdBarrier xbar = xcd_barrier_post((unsigned*)(P.ws + WS_BAR), bst);
#define GRID_BAR() xcd_barrier(xbar)
#define MK_TID() int tid = threadIdx.x; asm volatile("" : "+v"(tid)); const int lane = tid & 63, wave = __builtin_amdgcn_readfirstlane(tid >> 6); (void)lane; (void)wave
    unsigned char* ws = P.ws;
    const int G = gridDim.x, bid = blockIdx.x;

    { MK_TID(); p0_prologue(P, lds, tid, lane, wave); }
    grid.sync();

#ifndef NO_P1
    {
        if (bid == 0) {
            MK_TID();
            const int which = tid >> 8, n = tid & 255;
            const float* part = (const float*)(ws + WS_CPART) + (size_t)which * 64 * 256 + n;
            float s = (which ? P.b1_v : P.b1_k)[n];
#pragma unroll 8
            for (int kc = 0; kc < 64; ++kc) s += part[kc * 256];
            ((float*)(ws + WS_CBIAS))[which * 256 + n] = s;
        }
        pg8::Gemm g{(const bf16_t*)(ws + WS_XB), (const bf16_t*)(ws + WS_WIN), T, DINP, 1024, 1024};
        pg8::StaticOrder S; S.init(T, DINP, G, bid);
        EpiZ E{ws};
        pg8::gemm_phase<EpiZ, pg8::StaticOrder, true, true>(lds, g, S, E);
    }
#endif
    GRID_BAR();

    if (bid < 64) {
        const int which = bid & 1, c = bid >> 1;
        pg8::Gemm g{(const bf16_t*)(ws + (which ? WS_VC : WS_KC)), (const bf16_t*)(ws + (which ? WS_CW1V : WS_CW1K)), 8192, 256, 2048, 1024};
        pg8::StaticOrder S; S.init(8192, 256, 32, c);
        EpiC1 E{(bf16_t*)(ws + (which ? WS_H1V : WS_H1K)), (const float*)(ws + WS_CBIAS) + which * 256};
        pg8::gemm_phase<EpiC1, pg8::StaticOrder, true, true>(lds, g, S, E);
    }
    GRID_BAR();

    if (bid < 64) {
        const int which = bid & 1, c = bid >> 1;
        pg8::Gemm g{(const bf16_t*)(ws + (which ? WS_H1V : WS_H1K)), (const bf16_t*)(ws + (which ? WS_CW2V : WS_CW2K)), 8192, 256, 256, 256};
        pg8::StaticOrder S; S.init(8192, 256, 32, c);
        EpiC2 E{(bf16_t*)(ws + (which ? WS_VCMPT : WS_KCMP)), which};
        pg8::gemm_phase<EpiC2, pg8::StaticOrder, true, true>(lds, g, S, E);
    }
    GRID_BAR();

#ifndef NO_ATTN
    attn_phase(P, lds);
#ifdef PROBE_ATTN2
    GRID_BAR();
    attn_phase(P, lds, 1);
#endif
#endif
    GRID_BAR();

    {
        pg8::StaticOrder S; S.init(T, 1024, G, bid);
        { pg8::Gemm g{(const bf16_t*)(ws + WS_OA), (const bf16_t*)(ws + WS_WPA), T, 1024, 512, 512};
          EpiProj<false> E{(const bf16_t*)(ws + WS_GM), nullptr, (bf16_t*)(ws + WS_T1)};
          pg8::gemm_phase<EpiProj<false>, pg8::StaticOrder, true, true>(lds, g, S, E); }
        { pg8::Gemm g{(const bf16_t*)(ws + WS_OB), (const bf16_t*)(ws + WS_WPB), T, 1024, 512, 512};
          EpiProj<true> E{(const bf16_t*)(ws + WS_GM), (const bf16_t*)(ws + WS_T1), (bf16_t*)(ws + WS_Y)};
          pg8::gemm_phase<EpiProj<true>, pg8::StaticOrder, true, true>(lds, g, S, E); }
    }
    GRID_BAR();

    {
        pg8::Gemm g{(const bf16_t*)(ws + WS_Y), (const bf16_t*)(ws + WS_WOUT), T, 1024, 1024, 1024};
        pg8::StaticOrder S; S.init(T, 1024, G, bid);
        EpiRes E{P.x, (float*)(ws + WS_PRE1)};
        pg8::gemm_phase<EpiRes, pg8::StaticOrder, true, true>(lds, g, S, E);
    }
    GRID_BAR();

    { MK_TID(); ln_phase<true>((const float*)(ws + WS_PRE1), (float*)(ws + WS_HF), (bf16_t*)(ws + WS_HB), P.ln1g, P.ln1b, lane, wave); }
    GRID_BAR();

    {
        pg8::Gemm g{(const bf16_t*)(ws + WS_HB), (const bf16_t*)(ws + WS_WGU), T, NGU, 1024, 1024};
        pg8::StaticOrder S; S.init(T, NGU, G, bid);
        EpiGU E{(bf16_t*)(ws + WS_ACT)};
        pg8::gemm_phase<EpiGU, pg8::StaticOrder, true, true>(lds, g, S, E);
    }
    GRID_BAR();

    {
        pg8::Gemm g{(const bf16_t*)(ws + WS_ACT), (const bf16_t*)(ws + WS_WDN), T, 1024, FF, FF};
        pg8::StaticOrder S; S.init(T, 1024, G, bid);
        EpiRes E{(const float*)(ws + WS_HF), P.out};
        pg8::gemm_phase<EpiRes, pg8::StaticOrder, true, true>(lds, g, S, E);
    }
    GRID_BAR();

#ifdef PROBE_SYNC10
    for (int r = 0; r < 10; ++r) GRID_BAR();
#endif
    { MK_TID(); ln_phase<false>(P.out, P.out, nullptr, P.ln2g, P.ln2b, lane, wave); }
}
}

extern "C" void kernel_launch(void* const* d_in, const int* in_sizes, int n_in, void* d_out, int out_size, void* d_ws, size_t ws_size, hipStream_t stream) {
    static int grid = 0;
    if (grid == 0) {
        if (n_in != 21 || in_sizes[0] != mk::T * mk::D || out_size != mk::T * mk::D || ws_size < mk::WS_END) {
            fprintf(stderr, "kernel_launch: unexpected shapes (n_in %d, in0 %d, out %d, ws %zu); nothing launched\n", n_in, n_in > 0 ? in_sizes[0] : -1, out_size, ws_size); grid = -1; return; }
        int dev = 0, cus = 0, per_cu = 0;
        (void)hipGetDevice(&dev);
        (void)hipDeviceGetAttribute(&cus, hipDeviceAttributeMultiprocessorCount, dev);
        if (hipFuncSetAttribute((const void*)mk::fwd_megakernel, hipFuncAttributeMaxDynamicSharedMemorySize, mk::LDS_BYTES) != hipSuccess) { fprintf(stderr, "kernel_launch: hipFuncSetAttribute failed\n"); grid = -1; return; }
        if (hipOccupancyMaxActiveBlocksPerMultiprocessor(&per_cu, (const void*)mk::fwd_megakernel, mk::NTHREADS, mk::LDS_BYTES) != hipSuccess || per_cu < 1) { fprintf(stderr, "kernel_launch: occupancy query failed (%d)\n", per_cu); grid = -1; return; }
        grid = cus * (per_cu > 1 ? 1 : per_cu);
    }
    if (grid < 0) return;
    if (hipMemsetAsync((char*)d_ws + mk::WS_CTL, 0, 64 * 1024, stream) != hipSuccess) { fprintf(stderr, "kernel_launch: hipMemsetAsync failed\n"); return; }
    mk::Params p{};
    const float** pp = (const float**)&p;
    for (int i = 0; i < 21; ++i) pp[i] = (const float*)d_in[i];
    p.out = (float*)d_out; p.ws = (unsigned char*)d_ws;
    void* args[] = {&p};
    const hipError_t e = hipLaunchCooperativeKernel((const void*)mk::fwd_megakernel, dim3(grid), dim3(mk::NTHREADS), args, mk::LDS_BYTES, stream);
    if (e != hipSuccess) fprintf(stderr, "kernel_launch: cooperative launch failed: %s (grid %d)\n", hipGetErrorString(e), grid);
}
```
